# Optimizing an MI355X kernel written in HIP

```python
import math
import jax, jax.numpy as jnp
from jax import lax
import numpy as np

D_MODEL = 1024
BATCH = 16
SEQ = 2048
DEPTH = 2

N_EVEN = (DEPTH + 1) // 2
N_ODD = DEPTH // 2
D_FF = 2816
RMS_EPS = 1e-6
LN_EPS = 1e-5
MIX_WIDTH = D_MODEL
CONV_CH = MIX_WIDTH // 2
CONV_TAPS = 31
SSM_WIDTH = MIX_WIDTH - CONV_CH
SSM_GROUP = 16
SSM_GROUPS = SSM_WIDTH // SSM_GROUP
SSM_STATE = 64
DT_MIN = 1e-3
DT_MAX = 1e-1
IN_WIDTH = 2 * CONV_CH + SSM_WIDTH
N_HEADS = 8
HEAD_DIM = D_MODEL // N_HEADS
MOBA_BLOCK = 256
MOBA_TOPK = 3
Q_CHUNK = 8

kernel_name = "hybrid_conv_s5_moba_macaron"


def rms_norm(x, g):
    xf = x.astype(jnp.float32)
    y = xf * lax.rsqrt(jnp.mean(xf * xf, axis=-1, keepdims=True) + RMS_EPS)
    return (y * g.astype(jnp.float32)).astype(x.dtype)


def swiglu(h, w1, w3, w2):
    return (jax.nn.silu(h @ w1) * (h @ w3)) @ w2


def conformer_conv(a, g, conv_w, conv_b, ln_g, ln_b):
    v = a * jax.nn.sigmoid(g)
    y = lax.conv_general_dilated(
        v, conv_w[:, None, :].astype(v.dtype), window_strides=(1,),
        padding=[(CONV_TAPS - 1, 0)], dimension_numbers=("NWC", "WIO", "NWC"),
        feature_group_count=CONV_CH) + conv_b
    yf = y.astype(jnp.float32)
    mu = jnp.mean(yf, axis=-1, keepdims=True)
    var = jnp.mean(jnp.square(yf - mu), axis=-1, keepdims=True)
    yn = (yf - mu) * lax.rsqrt(var + LN_EPS) * ln_g.astype(jnp.float32) + ln_b.astype(jnp.float32)
    return jax.nn.silu(yn).astype(a.dtype)


def _complex_linear_combine(e1, e2):
    a1r, a1i, b1r, b1i = e1
    a2r, a2i, b2r, b2i = e2
    ar = a1r * a2r - a1i * a2i
    ai = a1r * a2i + a1i * a2r
    br = a2r * b1r - a2i * b1i + b2r
    bi = a2r * b1i + a2i * b1r + b2i
    return (ar, ai, br, bi)


def s5_ssm(u, a_re, a_im, b_re, b_im, c_re, c_im, d, log_dt, glu_w, glu_b):
    f32 = jnp.float32
    bsz, L, _ = u.shape
    a_re, a_im = a_re.astype(f32), a_im.astype(f32)
    b_re, b_im = b_re.astype(f32), b_im.astype(f32)
    c_re, c_im = c_re.astype(f32), c_im.astype(f32)
    dt = jnp.exp(log_dt.astype(f32))[:, None]
    mag = jnp.exp(dt * a_re)
    ang = dt * a_im
    abar_re = mag * jnp.cos(ang)
    abar_im = mag * jnp.sin(ang)
    den = a_re * a_re + a_im * a_im
    nr = abar_re - 1.0
    ni = abar_im
    q_re = (nr * a_re + ni * a_im) / den
    q_im = (ni * a_re - nr * a_im) / den
    bbar_re = q_re[..., None] * b_re - q_im[..., None] * b_im
    bbar_im = q_re[..., None] * b_im + q_im[..., None] * b_re
    uf = u.astype(f32)
    ug = uf.reshape(bsz, L, SSM_GROUPS, SSM_GROUP)
    bu_re = jnp.einsum("blgh,gph->blgp", ug, bbar_re)
    bu_im = jnp.einsum("blgh,gph->blgp", ug, bbar_im)
    a_seq_re = jnp.broadcast_to(abar_re[None, None], (1, L, SSM_GROUPS, SSM_STATE))
    a_seq_im = jnp.broadcast_to(abar_im[None, None], (1, L, SSM_GROUPS, SSM_STATE))
    _, _, x_re, x_im = lax.associative_scan(
        _complex_linear_combine, (a_seq_re, a_seq_im, bu_re, bu_im), axis=1)
    y = jnp.einsum("blgp,ghp->blgh", x_re, c_re) - jnp.einsum("blgp,ghp->blgh", x_im, c_im)
    y = y.reshape(bsz, L, SSM_WIDTH) + d.astype(f32) * uf
    y = jax.nn.gelu(y)
    y = y * jax.nn.sigmoid(y @ glu_w.astype(f32) + glu_b.astype(f32))
    return y.astype(u.dtype)


def conv_ssm_mixer(h, w_in, conv_w, conv_b, ln_g, ln_b, a_re, a_im, b_re, b_im,
                   c_re, c_im, d, log_dt, glu_w, glu_b, w_out):
    p = h @ w_in
    a = p[..., :CONV_CH]
    g = p[..., CONV_CH:2 * CONV_CH]
    u = p[..., 2 * CONV_CH:]
    y_conv = conformer_conv(a, g, conv_w, conv_b, ln_g, ln_b)
    y_ssm = s5_ssm(u, a_re, a_im, b_re, b_im, c_re, c_im, d, log_dt, glu_w, glu_b)
    return jnp.concatenate([y_conv, y_ssm], axis=-1) @ w_out


def moba_attention(h, w_qkv, w_o):
    f32 = jnp.float32
    bsz, L, _ = h.shape
    qkv = (h @ w_qkv).reshape(bsz, L, 3, N_HEADS, HEAD_DIM)
    q = qkv[:, :, 0].transpose(0, 2, 1, 3)
    k = qkv[:, :, 1].transpose(0, 2, 1, 3)
    v = qkv[:, :, 2].transpose(0, 2, 1, 3)
    n_blk = -(-L // MOBA_BLOCK)
    pad = n_blk * MOBA_BLOCK - L
    kp = jnp.pad(k, ((0, 0), (0, 0), (0, pad), (0, 0)))
    vp = jnp.pad(v, ((0, 0), (0, 0), (0, pad), (0, 0)))
    kb = kp.reshape(bsz, N_HEADS, n_blk, MOBA_BLOCK, HEAD_DIM)
    vb = vp.reshape(bsz, N_HEADS, n_blk, MOBA_BLOCK, HEAD_DIM)
    k_mean = jnp.mean(kb.astype(f32), axis=3)
    gate = jnp.einsum("bhqd,bhnd->bhqn", q.astype(f32), k_mean)
    q_blk = jnp.arange(L) // MOBA_BLOCK
    fully_past = jnp.arange(n_blk)[None, :] < q_blk[:, None]
    gate = jnp.where(fully_past, gate, -jnp.inf)
    n_sel = min(MOBA_TOPK, n_blk)
    g_val, g_idx = lax.top_k(gate, n_sel)
    g_ok = jnp.isfinite(g_val)
    scale = HEAD_DIM ** -0.5
    b_ix = jnp.arange(bsz)[:, None, None, None]
    h_ix = jnp.arange(N_HEADS)[None, :, None, None]

    def chunk(c):
        start = c * Q_CHUNK
        qc = lax.dynamic_slice_in_dim(q, start, Q_CHUNK, axis=2)
        idx = lax.dynamic_slice_in_dim(g_idx, start, Q_CHUNK, axis=2)
        ok = lax.dynamic_slice_in_dim(g_ok, start, Q_CHUNK, axis=2)
        k_sel = kb[b_ix, h_ix, idx]
        v_sel = vb[b_ix, h_ix, idx]
        s_sel = jnp.einsum("bhqd,bhqskd->bhqsk", qc, k_sel).astype(f32) * scale
        s_sel = jnp.where(ok[..., None], s_sel, -jnp.inf)
        s_sel = s_sel.reshape(bsz, N_HEADS, Q_CHUNK, n_sel * MOBA_BLOCK)
        own_start = (start // MOBA_BLOCK) * MOBA_BLOCK
        k_own = lax.dynamic_slice_in_dim(kp, own_start, MOBA_BLOCK, axis=2)
        v_own = lax.dynamic_slice_in_dim(vp, own_start, MOBA_BLOCK, axis=2)
        s_own = jnp.einsum("bhqd,bhkd->bhqk", qc, k_own).astype(f32) * scale
        causal = (own_start + jnp.arange(MOBA_BLOCK))[None, :] <= (start + jnp.arange(Q_CHUNK))[:, None]
        s_own = jnp.where(causal, s_own, -jnp.inf)
        p = jax.nn.softmax(jnp.concatenate([s_sel, s_own], axis=-1), axis=-1).astype(v.dtype)
        p_sel = p[..., :n_sel * MOBA_BLOCK].reshape(bsz, N_HEADS, Q_CHUNK, n_sel, MOBA_BLOCK)
        p_own = p[..., n_sel * MOBA_BLOCK:]
        return (jnp.einsum("bhqsk,bhqskd->bhqd", p_sel, v_sel)
                + jnp.einsum("bhqk,bhkd->bhqd", p_own, v_own))

    out = lax.map(chunk, jnp.arange(L // Q_CHUNK))
    out = out.transpose(1, 0, 3, 2, 4).reshape(bsz, L, N_HEADS * HEAD_DIM)
    return out @ w_o


def setup_inputs(seed: int = 0) -> dict:
    key = jax.random.key(seed)
    ks = jax.random.split(key, 26)
    f32 = jnp.float32

    def nrm(k, shape, scale):
        return jax.random.normal(k, shape, f32) * scale

    x = nrm(ks[0], (BATCH, SEQ, D_MODEL), 1.0)
    ffn_norm = 1.0 + nrm(ks[1], (DEPTH, 2, D_MODEL), 0.02)
    ffn_w1 = nrm(ks[2], (DEPTH, 2, D_MODEL, D_FF), D_MODEL ** -0.5)
    ffn_w3 = nrm(ks[3], (DEPTH, 2, D_MODEL, D_FF), D_MODEL ** -0.5)
    ffn_w2 = nrm(ks[4], (DEPTH, 2, D_FF, D_MODEL), D_FF ** -0.5)
    mix_norm = 1.0 + nrm(ks[5], (DEPTH, D_MODEL), 0.02)
    ab_w_in = nrm(ks[6], (N_EVEN, D_MODEL, IN_WIDTH), D_MODEL ** -0.5)
    conv_w = nrm(ks[7], (N_EVEN, CONV_TAPS, CONV_CH), CONV_TAPS ** -0.5)
    conv_b = nrm(ks[8], (N_EVEN, CONV_CH), 0.02)
    conv_ln_g = 1.0 + nrm(ks[9], (N_EVEN, CONV_CH), 0.02)
    conv_ln_b = nrm(ks[10], (N_EVEN, CONV_CH), 0.02)
    n_idx = jnp.arange(SSM_STATE, dtype=f32)
    ssm_a_re = -0.5 + nrm(ks[11], (N_EVEN, SSM_GROUPS, SSM_STATE), 0.01)
    ssm_a_im = math.pi * n_idx + nrm(ks[12], (N_EVEN, SSM_GROUPS, SSM_STATE), 0.01)
    ssm_b_re = nrm(ks[13], (N_EVEN, SSM_GROUPS, SSM_STATE, SSM_GROUP), (2 * SSM_GROUP) ** -0.5)
    ssm_b_im = nrm(ks[14], (N_EVEN, SSM_GROUPS, SSM_STATE, SSM_GROUP), (2 * SSM_GROUP) ** -0.5)
    ssm_c_re = nrm(ks[15], (N_EVEN, SSM_GROUPS, SSM_GROUP, SSM_STATE), (2 * SSM_STATE) ** -0.5)
    ssm_c_im = nrm(ks[16], (N_EVEN, SSM_GROUPS, SSM_GROUP, SSM_STATE), (2 * SSM_STATE) ** -0.5)
    ssm_d = nrm(ks[17], (N_EVEN, SSM_WIDTH), 1.0)
    ssm_log_dt = jax.random.uniform(ks[18], (N_EVEN, SSM_GROUPS), f32,
                                    minval=math.log(DT_MIN), maxval=math.log(DT_MAX))
    ssm_glu_w = nrm(ks[19], (N_EVEN, SSM_WIDTH, SSM_WIDTH), SSM_WIDTH ** -0.5)
    ssm_glu_b = nrm(ks[20], (N_EVEN, SSM_WIDTH), 0.02)
    ab_w_out = nrm(ks[21], (N_EVEN, MIX_WIDTH, D_MODEL), MIX_WIDTH ** -0.5)
    attn_w_qkv = nrm(ks[22], (N_ODD, D_MODEL, 3 * N_HEADS * HEAD_DIM), D_MODEL ** -0.5)
    attn_w_o = nrm(ks[23], (N_ODD, N_HEADS * HEAD_DIM, D_MODEL), (N_HEADS * HEAD_DIM) ** -0.5)
    final_norm = 1.0 + nrm(ks[24], (D_MODEL,), 0.02)
    return {"x": x, "ffn_norm": ffn_norm, "ffn_w1": ffn_w1, "ffn_w3": ffn_w3, "ffn_w2": ffn_w2,
            "mix_norm": mix_norm, "ab_w_in": ab_w_in, "conv_w": conv_w, "conv_b": conv_b,
            "conv_ln_g": conv_ln_g, "conv_ln_b": conv_ln_b, "ssm_a_re": ssm_a_re,
            "ssm_a_im": ssm_a_im, "ssm_b_re": ssm_b_re, "ssm_b_im": ssm_b_im,
            "ssm_c_re": ssm_c_re, "ssm_c_im": ssm_c_im, "ssm_d": ssm_d,
            "ssm_log_dt": ssm_log_dt, "ssm_glu_w": ssm_glu_w, "ssm_glu_b": ssm_glu_b,
            "ab_w_out": ab_w_out, "attn_w_qkv": attn_w_qkv, "attn_w_o": attn_w_o,
            "final_norm": final_norm}


def reference(x, ffn_norm, ffn_w1, ffn_w3, ffn_w2, mix_norm, ab_w_in, conv_w, conv_b,
              conv_ln_g, conv_ln_b, ssm_a_re, ssm_a_im, ssm_b_re, ssm_b_im, ssm_c_re,
              ssm_c_im, ssm_d, ssm_log_dt, ssm_glu_w, ssm_glu_b, ab_w_out, attn_w_qkv,
              attn_w_o, final_norm):
    for l in range(DEPTH):
        h = rms_norm(x, ffn_norm[l, 0])
        x = x + 0.5 * swiglu(h, ffn_w1[l, 0], ffn_w3[l, 0], ffn_w2[l, 0])
        h = rms_norm(x, mix_norm[l])
        if l % 2 == 0:
            e = l // 2
            x = x + conv_ssm_mixer(h, ab_w_in[e], conv_w[e], conv_b[e], conv_ln_g[e], conv_ln_b[e],
                                   ssm_a_re[e], ssm_a_im[e], ssm_b_re[e], ssm_b_im[e],
                                   ssm_c_re[e], ssm_c_im[e], ssm_d[e], ssm_log_dt[e],
                                   ssm_glu_w[e], ssm_glu_b[e], ab_w_out[e])
        else:
            o = l // 2
            x = x + moba_attention(h, attn_w_qkv[o], attn_w_o[o])
        h = rms_norm(x, ffn_norm[l, 1])
        x = x + 0.5 * swiglu(h, ffn_w1[l, 1], ffn_w3[l, 1], ffn_w2[l, 1])
    return rms_norm(x, final_norm)
```

```cpp
#include <hip/hip_runtime.h>
#include <hip/hip_cooperative_groups.h>
#include <cstdio>
#include <cstdint>
namespace cg = cooperative_groups;
namespace pg8 {
#define PG8_LAS __attribute__((address_space(3)))
typedef unsigned short bf16_t;
typedef short bf16x8 __attribute__((ext_vector_type(8)));
typedef float f32x4 __attribute__((ext_vector_type(4)));
typedef unsigned u32x4 __attribute__((ext_vector_type(4)));
constexpr int BM = 256, BK = 64, HALF = 128, HTB = HALF * BK * 2  , STAGE_BYTES = 8 * HTB, NXCD = 8, WGM = 8;

__host__ __device__ __forceinline__ int lds_byte(int r, int c) { const int st = (r >> 4) * 2 + (c >> 5), rr = r & 15, cc = c & 31, ob = rr * 64 + cc * 2; return st * 1024 + (ob ^ (((ob >> 9) & 1) << 5)); }
__host__ __device__ __forceinline__ void stage_rc(int b, int& R, int& C) { const int st = b / 1024, sb = b % 1024, swz = sb ^ (((sb >> 9) & 1) << 5); R = (st >> 1) * 16 + swz / 64; C = (st & 1) * 32 + (swz % 64) / 2; }
__host__ __device__ __forceinline__ int perm32(int rho) { const int n = rho >> 4, i = rho & 15; return 8 * (i >> 2) + 4 * n + (i & 3); }

struct Unit { int pm, pn; };
struct Gemm { const bf16_t* A; const bf16_t* Bt; int M, N, K; };

struct StaticOrder {
    int nM, nN, nwg, G, c;
    __host__ __device__ void init(int M, int N, int G_, int c_) { nM = M / BM; nN = N / BM; nwg = nM * nN; G = G_; c = c_; }
    __host__ __device__ bool next(int i, Unit& u) const {
        const long L = (long)i * G + c; if (L >= nwg) return false;
        int wgid = (int)L; { const int q = nwg / NXCD, r = nwg % NXCD, xcd = wgid % NXCD, off = wgid / NXCD; wgid = (xcd < r ? xcd * (q + 1) : r * (q + 1) + (xcd - r) * q) + off; }
        const int nig = WGM * nN, gid = wgid / nig, fm = gid * WGM, gsz = (nM - fm) < WGM ? (nM - fm) : WGM;
        u.pm = fm + ((wgid % nig) % gsz); u.pn = (wgid % nig) / gsz; return true;
    }
    __device__ __forceinline__ void a_ready(const Unit&) const {}
    __device__ __forceinline__ void done(const Unit&) const {}
};

__device__ __forceinline__ unsigned cvt_pk_bf16(float lo, float hi) { unsigned r; asm volatile("v_cvt_pk_bf16_f32 %0, %1, %2" : "=v"(r) : "v"(lo), "v"(hi)); return r; }
typedef float f32x2 __attribute__((ext_vector_type(2)));
template <class Epi, class Sched, bool ALIGN_EPI = false, bool SP2 = false>
__device__ __forceinline__ void gemm_phase(PG8_LAS unsigned char* lds, const Gemm g, const Sched& S, const Epi& E) {
    const int tid = threadIdx.x, wid = __builtin_amdgcn_readfirstlane(tid >> 6), lane = tid & 63, wr = wid >> 2, wc = wid & 3, fr = lane & 15, fq = lane >> 4;
    const int K = g.K, nt = K / BK;
    unsigned voffA[2], voffB[2];
#pragma unroll
    for (int i = 0; i < 2; ++i) { int R, C; stage_rc(tid * 16 + i * 8192, R, C); const int Rb = Epi::PERM ? ((R & ~31) + perm32(R & 31)) : R;
        voffA[i] = (unsigned)(R * K + C) * 2u; voffB[i] = (unsigned)(Rb * K + C) * 2u; }
    const size_t kstep = (size_t)(BK * 2);
    const size_t hstep = (size_t)HALF * K * 2;
    const size_t tstep = 2 * hstep;
    const unsigned ldsw = (unsigned)wid * 1024u;
    const int aoff = lds_byte(wr * 64 + fr, fq * 8), boff = lds_byte(wc * 32 + fr, fq * 8);
#define PG8_SA(b, h) (((b) * 2 + (h)) * HTB)
#define PG8_SB(b, h) ((4 + (b) * 2 + (h)) * HTB)
#define PG8_STAGE(bufoff, gbase, voff) do { _Pragma("unroll") for (int _i = 0; _i < 2; ++_i) \
        __builtin_amdgcn_global_load_lds((const unsigned*)((const char*)(gbase) + (voff)[_i]), (PG8_LAS unsigned*)(lds + (bufoff) + ldsw + _i * 8192), 16, 0, 0); } while (0)
#define PG8_LDA(dst, b, h) do { _Pragma("unroll") for (int m = 0; m < 4; ++m) _Pragma("unroll") for (int k = 0; k < 2; ++k) dst[m][k] = *(const PG8_LAS bf16x8*)(lds + PG8_SA(b, h) + aoff + m * 2048 + k * 1024); } while (0)
#define PG8_LDB(dst, b, h) do { _Pragma("unroll") for (int n = 0; n < 2; ++n) _Pragma("unroll") for (int k = 0; k < 2; ++k) dst[n][k] = *(const PG8_LAS bf16x8*)(lds + PG8_SB(b, h) + boff + n * 2048 + k * 1024); } while (0)
#define PG8_MMA(ai, bj, At, Bt) do { __builtin_amdgcn_s_setprio(1); _Pragma("unroll") for (int m = 0; m < 4; ++m) _Pragma("unroll") for (int n = 0; n < 2; ++n) _Pragma("unroll") for (int k = 0; k < 2; ++k) \
        acc[ai][bj][m][n] = __builtin_amdgcn_mfma_f32_16x16x32_bf16(Bt[n][k], At[m][k], acc[ai][bj][m][n], 0, 0, 0); __builtin_amdgcn_s_setprio(0); } while (0)
#define PG8_WAIT_V(n) asm volatile("s_waitcnt vmcnt(" #n ")" ::: "memory")
#define PG8_WAIT_L(n) asm volatile("s_waitcnt lgkmcnt(" #n ")" ::: "memory")
#define PG8_BAR __builtin_amdgcn_s_barrier()
#define PG8_SCHED __builtin_amdgcn_sched_barrier(0)
    Unit cur, nxt; int ui = 0;
    if (!S.next(0, cur)) return;
    f32x4 acc[2][2][4][2];
#pragma unroll
    for (int a = 0; a < 2; ++a)
#pragma unroll
        for (int b = 0; b < 2; ++b)
#pragma unroll
            for (int m = 0; m < 4; ++m)
#pragma unroll
                for (int n = 0; n < 2; ++n) acc[a][b][m][n] = (f32x4){0.f, 0.f, 0.f, 0.f};
    bf16x8 At[4][2], B0[2][2], B1[2][2];
    const char* cA = (const char*)g.A + (size_t)cur.pm * tstep; const char* cB = (const char*)g.Bt + (size_t)cur.pn * tstep;
    S.a_ready(cur);
    if constexpr (SP2) {
        PG8_STAGE(PG8_SB(0, 0), cB, voffB); PG8_STAGE(PG8_SB(0, 1), cB + hstep, voffB); PG8_STAGE(PG8_SA(0, 0), cA, voffA); PG8_STAGE(PG8_SA(0, 1), cA + hstep, voffA);
        if (wr == 1) PG8_BAR;
        PG8_WAIT_V(2); PG8_BAR;
        PG8_STAGE(PG8_SB(1, 0), cB + kstep, voffB); PG8_STAGE(PG8_SA(1, 0), cA + kstep, voffA); PG8_STAGE(PG8_SB(1, 1), cB + hstep + kstep, voffB);
        PG8_WAIT_V(6); PG8_BAR;
    } else {
        PG8_STAGE(PG8_SB(0, 0), cB, voffB); PG8_STAGE(PG8_SA(0, 0), cA, voffA); PG8_STAGE(PG8_SB(0, 1), cB + hstep, voffB); PG8_STAGE(PG8_SA(0, 1), cA + hstep, voffA);
        if (wr == 1) PG8_BAR;
        PG8_WAIT_V(4); PG8_BAR;
        PG8_STAGE(PG8_SB(1, 0), cB + kstep, voffB); PG8_STAGE(PG8_SA(1, 0), cA + kstep, voffA); PG8_STAGE(PG8_SB(1, 1), cB + hstep + kstep, voffB);
        PG8_WAIT_V(6); PG8_BAR;
    }
    for (;;) {
        const bool has_next = S.next(ui + 1, nxt);
        const char* nA = has_next ? (const char*)g.A + (size_t)nxt.pm * tstep : cA; const char* nB = has_next ? (const char*)g.Bt + (size_t)nxt.pn * tstep : cB;
        for (int t = 0; t < nt; t += 2) {
            const bool last = (t == nt - 2);
            const char* a1 = cA + (size_t)(t + 1) * kstep;
            const char* a2 = last ? nA : cA + (size_t)(t + 2) * kstep; const char* b2 = last ? nB : cB + (size_t)(t + 2) * kstep;
            const char* a3 = a2 + kstep; const char* b3 = b2 + kstep;
            if (last && has_next) S.a_ready(nxt);
            if constexpr (SP2) {
            PG8_LDB(B0, 0, 0); PG8_LDB(B1, 0, 1); PG8_SCHED; PG8_LDA(At, 0, 0); PG8_STAGE(PG8_SA(1, 1), a1 + hstep, voffA);
            PG8_WAIT_V(8); PG8_WAIT_L(0); PG8_BAR; PG8_MMA(0, 0, At, B0); PG8_MMA(0, 1, At, B1); PG8_BAR; PG8_SCHED;
            PG8_LDA(At, 0, 1); PG8_STAGE(PG8_SB(0, 0), b2, voffB); PG8_STAGE(PG8_SB(0, 1), b2 + hstep, voffB); PG8_STAGE(PG8_SA(0, 0), a2, voffA);
            PG8_WAIT_V(8); PG8_WAIT_L(0); PG8_BAR; PG8_MMA(1, 0, At, B0); PG8_MMA(1, 1, At, B1); PG8_BAR; PG8_SCHED;
            PG8_LDB(B0, 1, 0); PG8_LDB(B1, 1, 1); PG8_SCHED; PG8_LDA(At, 1, 0); PG8_STAGE(PG8_SA(0, 1), a2 + hstep, voffA);
            PG8_WAIT_V(8); PG8_WAIT_L(0); PG8_BAR; PG8_MMA(0, 0, At, B0); PG8_MMA(0, 1, At, B1); PG8_BAR; PG8_SCHED;
            PG8_LDA(At, 1, 1); PG8_STAGE(PG8_SB(1, 0), b3, voffB); PG8_STAGE(PG8_SB(1, 1), b3 + hstep, voffB); PG8_STAGE(PG8_SA(1, 0), a3, voffA);
            PG8_WAIT_V(8); PG8_WAIT_L(0); PG8_BAR; PG8_MMA(1, 0, At, B0); PG8_MMA(1, 1, At, B1); PG8_BAR; PG8_SCHED;
            } else {
            PG8_LDB(B0, 0, 0); PG8_SCHED; PG8_LDA(At, 0, 0); PG8_STAGE(PG8_SA(1, 1), a1 + hstep, voffA);
            PG8_WAIT_L(8); PG8_BAR; PG8_WAIT_L(0); PG8_MMA(0, 0, At, B0); PG8_BAR; PG8_SCHED;
            PG8_LDB(B1, 0, 1); PG8_STAGE(PG8_SB(0, 0), b2, voffB);
            PG8_BAR; PG8_WAIT_L(0); PG8_MMA(0, 1, At, B1); PG8_BAR;
            PG8_LDA(At, 0, 1); PG8_STAGE(PG8_SA(0, 0), a2, voffA);
            PG8_BAR; PG8_WAIT_L(0); PG8_MMA(1, 0, At, B0); PG8_BAR; PG8_SCHED;
            PG8_STAGE(PG8_SB(0, 1), b2 + hstep, voffB);
            PG8_WAIT_V(6); PG8_BAR; PG8_MMA(1, 1, At, B1); PG8_BAR;
            PG8_LDB(B0, 1, 0); PG8_SCHED; PG8_LDA(At, 1, 0); PG8_STAGE(PG8_SA(0, 1), a2 + hstep, voffA);
            PG8_WAIT_L(8); PG8_BAR; PG8_WAIT_L(0); PG8_MMA(0, 0, At, B0); PG8_BAR; PG8_SCHED;
            PG8_LDB(B1, 1, 1); PG8_STAGE(PG8_SB(1, 0), b3, voffB);
            PG8_BAR; PG8_WAIT_L(0); PG8_MMA(0, 1, At, B1); PG8_BAR;
            PG8_LDA(At, 1, 1); PG8_STAGE(PG8_SA(1, 0), a3, voffA);
            PG8_BAR; PG8_WAIT_L(0); PG8_MMA(1, 0, At, B0); PG8_BAR; PG8_SCHED;
            PG8_STAGE(PG8_SB(1, 1), b3 + hstep, voffB);
            PG8_WAIT_V(6); PG8_BAR; PG8_MMA(1, 1, At, B1); PG8_BAR;
            }
        }
        if constexpr (ALIGN_EPI) { if (wr == 0) PG8_BAR; }
        if constexpr (!Epi::AFTER_DRAIN) { E(acc, cur, wr, wc, fr, fq); S.done(cur); }
        if (!has_next) break;
#pragma unroll
        for (int a = 0; a < 2; ++a)
#pragma unroll
            for (int b = 0; b < 2; ++b)
#pragma unroll
                for (int m = 0; m < 4; ++m)
#pragma unroll
                    for (int n = 0; n < 2; ++n) acc[a][b][m][n] = (f32x4){0.f, 0.f, 0.f, 0.f};
        cur = nxt; cA = nA; cB = nB; ++ui;
        if constexpr (ALIGN_EPI) { if (wr == 1) PG8_BAR; }
    }
    PG8_WAIT_V(0);
    if constexpr (!ALIGN_EPI) { if (wr == 0) PG8_BAR; }
    PG8_BAR;
    if constexpr (Epi::AFTER_DRAIN) { E.fused(acc, cur, wr, wc, fr, fq, lds, wid, lane); S.done(cur); }
#undef PG8_SA
#undef PG8_SB
#undef PG8_STAGE
#undef PG8_LDA
#undef PG8_LDB
#undef PG8_MMA
#undef PG8_WAIT_V
#undef PG8_WAIT_L
#undef PG8_BAR
#undef PG8_SCHED
}
}

#define LAS __attribute__((address_space(3)))
using pg8::bf16_t; using pg8::bf16x8; using pg8::f32x4; using pg8::u32x4; using pg8::cvt_pk_bf16;
typedef float f32x16 __attribute__((ext_vector_type(16)));
typedef float f32x2v __attribute__((ext_vector_type(2)));
typedef unsigned u32x2 __attribute__((ext_vector_type(2)));
constexpr int NB = 16, SEQ = 2048, T = NB * SEQ, D = 1024, FF = 2816;
constexpr int CONVC = 512, TAPS = 31, SSMW = 512, NG = 32, NS = 64, NH = 8, HD = 128;
constexpr int NWAVES = 8, NTHREADS = 512;
constexpr int LDS_BYTES = 147456;
constexpr int LDS_RTAB_OFF = 131072;
constexpr size_t MiB = 1u << 20;
constexpr size_t WS_KMEAN = 0, WS_SST = 2 * MiB, WS_SS = 88 * MiB;
constexpr size_t WS_WUP = 8 * MiB, WS_WDN = 52 * MiB, WS_WIN = 74 * MiB, WS_WGLU = 77 * MiB, WS_WOUT = 78 * MiB, WS_WQK = 80 * MiB, WS_WV = 84 * MiB, WS_WO = 86 * MiB;
constexpr size_t WUP_STRIDE = 11 * MiB, WDN_STRIDE = (size_t)D * FF * 2;
constexpr size_t WS_H = 104 * MiB, WS_BIG = 168 * MiB;
constexpr size_t WS_U = WS_BIG, WS_VC = WS_BIG, WS_US = WS_BIG + 32 * MiB, WS_YB = WS_BIG + 96 * MiB, WS_CAT = WS_BIG + 128 * MiB;
constexpr size_t WS_QK = WS_BIG, WS_VT = WS_BIG + 128 * MiB, WS_OA = WS_BIG + 192 * MiB, WS_END = WS_BIG + 256 * MiB;
constexpr float C2 = 0.08838834764831845f * 1.4426950408889634f;
constexpr float LOG2E = 1.4426950408889634f;

__device__ __forceinline__ float bf_lo(unsigned w) { return __builtin_bit_cast(float, w << 16); }
__device__ __forceinline__ float bf_hi(unsigned w) { return __builtin_bit_cast(float, w & 0xffff0000u); }
__device__ __forceinline__ float fast_sigmoid(float x) { return __builtin_amdgcn_rcpf(1.f + __builtin_amdgcn_exp2f(-x * LOG2E)); }
__device__ __forceinline__ float fast_silu(float x) { return x * fast_sigmoid(x); }
__device__ __forceinline__ float gelu_tanh(float x) { const float z = 0.7978845608028654f * (x + 0.044715f * x * x * x); const float e = __builtin_amdgcn_exp2f(2.f * LOG2E * z); return 0.5f * x * (2.f - 2.f * __builtin_amdgcn_rcpf(1.f + e)); }
__device__ __forceinline__ float rs_of(float ss) { return 1.0f / sqrtf(ss * (1.f / 1024.f) + 1e-6f); }
constexpr int SSN = 16 * T;
__device__ __forceinline__ float row_scale(const float* SSP, int row, int fq) {
    const float* p = SSP + (size_t)(4 * fq) * T + row; float t = (p[0] + p[T]) + (p[2 * T] + p[3 * T]);
    t += __shfl_xor(t, 16); t += __shfl_xor(t, 32); return rs_of(t);
}
__device__ __forceinline__ float wave_sum(float v) {
#pragma unroll
    for (int o = 1; o < 64; o <<= 1) v += __shfl_xor(v, o);
    return v;
}

typedef float f32x2c __attribute__((ext_vector_type(2))); typedef __bf16 bf16x2c __attribute__((ext_vector_type(2)));
__device__ __forceinline__ unsigned cvt_pk2(float lo, float hi) { f32x2c v = {lo, hi}; bf16x2c q = __builtin_convertvector(v, bf16x2c); return __builtin_bit_cast(unsigned, q); }
struct RTab { const LAS float* tab; int p0, p1, p2, p3;
    __device__ __forceinline__ const LAS float* of(int p) const { return tab + (p == p0 ? 0 : (p == p1 ? 1 : (p == p2 ? 2 : 3))) * 256; } };
struct EpiSwiglu {
    static constexpr bool PERM = true, AFTER_DRAIN = false; bf16_t* O; RTab rt_;
    __device__ __forceinline__ void operator()(const f32x4 (&acc)[2][2][4][2], const pg8::Unit& u, int wr, int wc, int fr, int fq) const {
        const int row0 = u.pm * 256 + wr * 64 + fr, col0 = u.pn * 128 + wc * 32 + 8 * fq;
        const LAS float* rt = rt_.of(u.pm) + wr * 64 + fr;
#pragma unroll
        for (int ai = 0; ai < 2; ++ai)
#pragma unroll
            for (int m = 0; m < 4; ++m) { bf16_t* rowp = O + (size_t)(row0 + ai * 128 + m * 16) * FF + col0; const float r = rt[ai * 128 + m * 16];
                const float rl = -r * LOG2E, r2 = r * r; unsigned w[4];
#pragma unroll
                for (int n = 0; n < 2; ++n)
#pragma unroll
                    for (int h = 0; h < 2; ++h) { const f32x2v g = {acc[ai][0][m][n][2 * h], acc[ai][0][m][n][2 * h + 1]}, uu = {acc[ai][1][m][n][2 * h], acc[ai][1][m][n][2 * h + 1]};
                        const f32x2v t = g * rl; f32x2v d = {__builtin_amdgcn_exp2f(t.x), __builtin_amdgcn_exp2f(t.y)}; d = d + 1.0f;
                        const f32x2v q = {__builtin_amdgcn_rcpf(d.x), __builtin_amdgcn_rcpf(d.y)}; const f32x2v o = ((g * uu) * r2) * q;
                        w[2 * n + h] = cvt_pk2(o.x, o.y); }
                u32x4 wv; wv.x = w[0]; wv.y = w[1]; wv.z = w[2]; wv.w = w[3];
                *(u32x4*)rowp = wv; }
    }
};
struct EpiResid {
    static constexpr bool PERM = true, AFTER_DRAIN = false; bf16_t* XB; float s; float* SSo;
    __device__ __forceinline__ void operator()(const f32x4 (&acc)[2][2][4][2], const pg8::Unit& u, int wr, int wc, int fr, int fq) const {
        const int row0 = u.pm * 256 + wr * 64 + fr, col0 = u.pn * 256 + wc * 32 + 8 * fq;
        u32x4 xin[2][4][2];
#pragma unroll
        for (int ai = 0; ai < 2; ++ai)
#pragma unroll
            for (int m = 0; m < 4; ++m)
#pragma unroll
                for (int bj = 0; bj < 2; ++bj) xin[ai][m][bj] = *(const u32x4*)(XB + (size_t)(row0 + ai * 128 + m * 16) * D + col0 + bj * 128);
        __builtin_amdgcn_sched_barrier(0);
#pragma unroll
        for (int ai = 0; ai < 2; ++ai)
#pragma unroll
            for (int m = 0; m < 4; ++m) { const size_t ro = (size_t)(row0 + ai * 128 + m * 16) * D + col0; float sq = 0.f;
#pragma unroll
                for (int bj = 0; bj < 2; ++bj) { const u32x4 xb = xin[ai][m][bj];
                    const f32x4 x0 = (f32x4){bf_lo(xb.x), bf_hi(xb.x), bf_lo(xb.y), bf_hi(xb.y)} + acc[ai][bj][m][0] * s, x1 = (f32x4){bf_lo(xb.z), bf_hi(xb.z), bf_lo(xb.w), bf_hi(xb.w)} + acc[ai][bj][m][1] * s;
                    sq += (x0[0] * x0[0] + x0[1] * x0[1]) + (x0[2] * x0[2] + x0[3] * x0[3]) + (x1[0] * x1[0] + x1[1] * x1[1]) + (x1[2] * x1[2] + x1[3] * x1[3]);
                    u32x4 w; w.x = cvt_pk2(x0[0], x0[1]); w.y = cvt_pk2(x0[2], x0[3]); w.z = cvt_pk2(x1[0], x1[1]); w.w = cvt_pk2(x1[2], x1[3]);
                    *(u32x4*)(XB + ro + bj * 128) = w; }
                sq += __shfl_xor(sq, 16); sq += __shfl_xor(sq, 32);
                if (fq == 0) SSo[(size_t)(u.pn * 4 + wc) * T + row0 + ai * 128 + m * 16] = sq; }
    }
};
struct EpiWin {
    static constexpr bool PERM = true, AFTER_DRAIN = false; bf16_t* VC; bf16_t* US; RTab rt_;
    __device__ __forceinline__ void operator()(const f32x4 (&acc)[2][2][4][2], const pg8::Unit& u, int wr, int wc, int fr, int fq) const {
        const int row0 = u.pm * 256 + wr * 64 + fr; const LAS float* rt = rt_.of(u.pm) + wr * 64 + fr;
        if (u.pn < 4) { const int col0 = u.pn * 128 + wc * 32 + 8 * fq;
#pragma unroll
            for (int ai = 0; ai < 2; ++ai)
#pragma unroll
                for (int m = 0; m < 4; ++m) { bf16_t* rowp = VC + (size_t)(row0 + ai * 128 + m * 16) * CONVC + col0; const float r = rt[ai * 128 + m * 16];
                    const f32x4 a0 = acc[ai][0][m][0] * r, a1 = acc[ai][0][m][1] * r, g0 = acc[ai][1][m][0] * r, g1 = acc[ai][1][m][1] * r;
                    u32x4 w; w.x = cvt_pk_bf16(a0[0] * fast_sigmoid(g0[0]), a0[1] * fast_sigmoid(g0[1])); w.y = cvt_pk_bf16(a0[2] * fast_sigmoid(g0[2]), a0[3] * fast_sigmoid(g0[3]));
                    w.z = cvt_pk_bf16(a1[0] * fast_sigmoid(g1[0]), a1[1] * fast_sigmoid(g1[1])); w.w = cvt_pk_bf16(a1[2] * fast_sigmoid(g1[2]), a1[3] * fast_sigmoid(g1[3]));
                    *(u32x4*)rowp = w; }
        } else { const int col0 = (u.pn - 4) * 256 + wc * 32 + 8 * fq;
#pragma unroll
            for (int ai = 0; ai < 2; ++ai)
#pragma unroll
                for (int m = 0; m < 4; ++m) { bf16_t* rowp = US + (size_t)(row0 + ai * 128 + m * 16) * SSMW + col0; const float r = rt[ai * 128 + m * 16];
#pragma unroll
                    for (int bj = 0; bj < 2; ++bj) { const f32x4 v0 = acc[ai][bj][m][0] * r, v1 = acc[ai][bj][m][1] * r;
                        u32x4 w; w.x = cvt_pk_bf16(v0[0], v0[1]); w.y = cvt_pk_bf16(v0[2], v0[3]); w.z = cvt_pk_bf16(v1[0], v1[1]); w.w = cvt_pk_bf16(v1[2], v1[3]);
                        *(u32x4*)(rowp + bj * 128) = w; } }
        }
    }
};
struct EpiBf {
    static constexpr bool PERM = true, AFTER_DRAIN = false; bf16_t* O; int ldc; int nscaled; float sc; RTab rt_; float* KMs;
    __device__ __forceinline__ void operator()(const f32x4 (&acc)[2][2][4][2], const pg8::Unit& u, int wr, int wc, int fr, int fq) const {
        const int row0 = u.pm * 256 + wr * 64 + fr, col0 = u.pn * 256 + wc * 32 + 8 * fq; const float s = (u.pn < nscaled) ? sc : 1.f; const LAS float* rt = rt_.of(u.pm) + wr * 64 + fr;
        f32x4 cs[2][2];
#pragma unroll
        for (int bj = 0; bj < 2; ++bj)
#pragma unroll
            for (int n = 0; n < 2; ++n) cs[bj][n] = (f32x4){0.f, 0.f, 0.f, 0.f};
#pragma unroll
        for (int ai = 0; ai < 2; ++ai)
#pragma unroll
            for (int m = 0; m < 4; ++m) { bf16_t* rowp = O + (size_t)(row0 + ai * 128 + m * 16) * ldc + col0; const float r = s * rt[ai * 128 + m * 16];
#pragma unroll
                for (int bj = 0; bj < 2; ++bj) { const f32x4 v0 = acc[ai][bj][m][0] * r, v1 = acc[ai][bj][m][1] * r; cs[bj][0] += v0; cs[bj][1] += v1;
                    u32x4 w; w.x = cvt_pk_bf16(v0[0], v0[1]); w.y = cvt_pk_bf16(v0[2], v0[3]); w.z = cvt_pk_bf16(v1[0], v1[1]); w.w = cvt_pk_bf16(v1[2], v1[3]);
                    *(u32x4*)(rowp + bj * 128) = w; } }
        if (KMs && u.pn >= 4) {
#pragma unroll
            for (int bj = 0; bj < 2; ++bj)
#pragma unroll
                for (int n = 0; n < 2; ++n)
#pragma unroll
                    for (int e = 0; e < 4; ++e) { float t = cs[bj][n][e]; t += __shfl_xor(t, 1); t += __shfl_xor(t, 2); t += __shfl_xor(t, 4); t += __shfl_xor(t, 8);
                        if (fr == 0) { const int c = col0 + bj * 128 + 4 * n + e - 1024; unsafeAtomicAdd(KMs + ((size_t)((u.pm >> 3) * NH + (c >> 7)) * 8 + (u.pm & 7)) * HD + (c & 127), t); } }
        }
    }
};
struct EpiVT {
    static constexpr bool PERM = true, AFTER_DRAIN = false; bf16_t* O; RTab rt_;
    __device__ __forceinline__ void operator()(const f32x4 (&acc)[2][2][4][2], const pg8::Unit& u, int wr, int wc, int fr, int fq) const {
        const int row0 = u.pm * 256 + wr * 64 + fr, col0 = u.pn * 256 + wc * 32 + 8 * fq;
        f32x4 rv[2][2]; const LAS float* rt = rt_.of(u.pn) + wc * 32 + 8 * fq;
#pragma unroll
        for (int bj = 0; bj < 2; ++bj)
#pragma unroll
            for (int n = 0; n < 2; ++n) rv[bj][n] = *(const LAS f32x4*)(rt + bj * 128 + 4 * n);
#pragma unroll
        for (int ai = 0; ai < 2; ++ai)
#pragma unroll
            for (int m = 0; m < 4; ++m) { const int dg = row0 + ai * 128 + m * 16, hh = dg >> 7, d = dg & 127;
#pragma unroll
                for (int bj = 0; bj < 2; ++bj) { const int tok = col0 + bj * 128, bb = tok >> 11, tl = tok & 2047;
                    const f32x4 v0 = acc[ai][bj][m][0] * rv[bj][0], v1 = acc[ai][bj][m][1] * rv[bj][1];
                    u32x4 w; w.x = cvt_pk_bf16(v0[0], v0[1]); w.y = cvt_pk_bf16(v0[2], v0[3]); w.z = cvt_pk_bf16(v1[0], v1[1]); w.w = cvt_pk_bf16(v1[2], v1[3]);
                    *(u32x4*)(O + ((((size_t)(bb * 8 + hh) * 32 + (tl >> 6)) * 128 + d) * 64 + (tl & 63))) = w; } }
    }
};
struct EpiGlu {
    static constexpr bool PERM = true, AFTER_DRAIN = false; const bf16_t* YB; const float* bias; bf16_t* CAT;
    __device__ __forceinline__ void operator()(const f32x4 (&acc)[2][2][4][2], const pg8::Unit& u, int wr, int wc, int fr, int fq) const {
        const int row0 = u.pm * 256 + wr * 64 + fr, col0 = u.pn * 256 + wc * 32 + 8 * fq;
#pragma unroll
        for (int bj = 0; bj < 2; ++bj) { const int c = col0 + bj * 128; const f32x4 b0 = *(const f32x4*)(bias + c), b1 = *(const f32x4*)(bias + c + 4);
#pragma unroll
            for (int ai = 0; ai < 2; ++ai)
#pragma unroll
                for (int m = 0; m < 4; ++m) { const size_t r = (size_t)(row0 + ai * 128 + m * 16);
                    const u32x4 y = *(const u32x4*)(YB + r * SSMW + c); const f32x4 v0 = acc[ai][bj][m][0] + b0, v1 = acc[ai][bj][m][1] + b1;
                    u32x4 w; w.x = cvt_pk_bf16(bf_lo(y.x) * fast_sigmoid(v0[0]), bf_hi(y.x) * fast_sigmoid(v0[1])); w.y = cvt_pk_bf16(bf_lo(y.y) * fast_sigmoid(v0[2]), bf_hi(y.y) * fast_sigmoid(v0[3]));
                    w.z = cvt_pk_bf16(bf_lo(y.z) * fast_sigmoid(v1[0]), bf_hi(y.z) * fast_sigmoid(v1[1])); w.w = cvt_pk_bf16(bf_lo(y.w) * fast_sigmoid(v1[2]), bf_hi(y.w) * fast_sigmoid(v1[3]));
                    *(u32x4*)(CAT + r * D + 512 + c) = w; } }
    }
};

struct TrDesc { const float* W; const float* gain; bf16_t* WT; int ldw, K, drow0, k0, n0; };
__device__ __forceinline__ TrDesc tr_desc(const float* W, int ldw, int K, bf16_t* WT, int nblk, int mode, int arg, const float* gain, int item) {
    TrDesc d; const int kb = item / nblk, nb = item % nblk; d.k0 = 64 * kb; d.n0 = 32 * nb; d.W = W; d.gain = gain; d.WT = WT; d.ldw = ldw; d.K = K;
    d.drow0 = mode == 0 ? arg + d.n0 : (d.n0 >> 7) * 256 + arg * 128 + (d.n0 & 127); return d;
}
__device__ __forceinline__ void tr_load(const TrDesc& d, float (&v)[32], int lane) {
#pragma unroll
    for (int i = 0; i < 32; ++i) { const int kk = 2 * i + (lane >> 5); v[i] = d.W[(size_t)(d.k0 + kk) * d.ldw + d.n0 + (lane & 31)]; }
}
__device__ __forceinline__ void tr_store(const TrDesc& d, float (&v)[32], LAS float* scr, int lane) {
    if (d.gain) {
#pragma unroll
        for (int i = 0; i < 32; ++i) v[i] *= d.gain[d.k0 + 2 * i + (lane >> 5)]; }
#pragma unroll
    for (int i = 0; i < 32; ++i) { const int kk = 2 * i + (lane >> 5); scr[kk * 33 + (lane & 31)] = v[i]; }
    asm volatile("s_waitcnt lgkmcnt(0)" ::: "memory");
    const int c = lane & 7;
#pragma unroll
    for (int j = 0; j < 4; ++j) { const int n = (lane >> 3) + 8 * j; const LAS float* s = scr + (8 * c) * 33 + n;
        u32x4 o; o.x = cvt_pk_bf16(s[0 * 33], s[1 * 33]); o.y = cvt_pk_bf16(s[2 * 33], s[3 * 33]); o.z = cvt_pk_bf16(s[4 * 33], s[5 * 33]); o.w = cvt_pk_bf16(s[6 * 33], s[7 * 33]);
        *(u32x4*)(d.WT + (size_t)(d.drow0 + n) * d.K + d.k0 + 8 * c) = o; }
    asm volatile("s_waitcnt lgkmcnt(0)" ::: "memory");
}

__device__ __forceinline__ void xb_rows(const float* X, bf16_t* XB, float* SS0, int gw, int NGW, int lane) {
    for (int m0 = 4 * gw; m0 < T; m0 += 4 * NGW) { f32x4 v[4][4];
#pragma unroll
        for (int q = 0; q < 4; ++q)
#pragma unroll
            for (int j = 0; j < 4; ++j) v[q][j] = ((const f32x4*)(X + (size_t)(m0 + q) * D) + lane)[64 * j];
#pragma unroll
        for (int q = 0; q < 4; ++q) { float s = 0.f;
#pragma unroll
            for (int j = 0; j < 4; ++j) s += (v[q][j].x * v[q][j].x + v[q][j].y * v[q][j].y) + (v[q][j].z * v[q][j].z + v[q][j].w * v[q][j].w);
            s = wave_sum(s); if (lane < 16) SS0[(size_t)lane * T + m0 + q] = (lane == 0) ? s : 0.f;
            u32x2* o = (u32x2*)(XB + (size_t)(m0 + q) * D) + lane;
#pragma unroll
            for (int j = 0; j < 4; ++j) { u32x2 w; w.x = cvt_pk_bf16(v[q][j].x, v[q][j].y); w.y = cvt_pk_bf16(v[q][j].z, v[q][j].w); o[64 * j] = w; } } }
}
__device__ __forceinline__ void final_rows(const bf16_t* XB, float* out, const float* g, const float* SS, int gw, int NGW, int lane) {
    f32x4 gv[4];
#pragma unroll
    for (int j = 0; j < 4; ++j) gv[j] = ((const f32x4*)g)[lane + 64 * j];
    for (int m0 = 4 * gw; m0 < T; m0 += 4 * NGW) {
        u32x2 w[4][4]; float tp[4];
#pragma unroll
        for (int q = 0; q < 4; ++q) { const u32x2* xr = (const u32x2*)(XB + (size_t)(m0 + q) * D) + lane;
#pragma unroll
            for (int j = 0; j < 4; ++j) w[q][j] = xr[64 * j];
            tp[q] = (lane < 16) ? SS[(size_t)lane * T + m0 + q] : 0.f; }
#pragma unroll
        for (int q = 0; q < 4; ++q) { float t = tp[q]; t += __shfl_xor(t, 1); t += __shfl_xor(t, 2); t += __shfl_xor(t, 4); t += __shfl_xor(t, 8); const float r = rs_of(__shfl(t, 0));
            f32x4* o = (f32x4*)(out + (size_t)(m0 + q) * D) + lane;
#pragma unroll
            for (int j = 0; j < 4; ++j) o[64 * j] = (f32x4){bf_lo(w[q][j].x), bf_hi(w[q][j].x), bf_lo(w[q][j].y), bf_hi(w[q][j].y)} * r * gv[j]; } }
}

__device__ __forceinline__ void conv_phase(LAS unsigned char* lds, const bf16_t* VC, const float* cw, const float* cb, const float* lng, const float* lnb, bf16_t* CAT, int tid, int lane, int wave) {
    const int cp = tid & 255, th = tid >> 8;
    f32x2v wk[TAPS];
#pragma unroll
    for (int k = 0; k < TAPS; ++k) wk[k] = *(const f32x2v*)(cw + k * CONVC + 2 * cp);
    const f32x2v bias = *(const f32x2v*)(cb + 2 * cp);
    LAS float* ybuf = (LAS float*)lds;
    unsigned vn[38];
#define CONV_LOAD(dst, it_) do { const int t0_ = (it_) * 16 + th * 8, tb_ = t0_ & (SEQ - 1); \
        _Pragma("unroll") for (int r = 0; r < 38; ++r) { const int pos = tb_ - 30 + r; dst[r] = *(const unsigned*)(VC + (size_t)(t0_ - tb_ + (pos < 0 ? 0 : pos)) * CONVC + 2 * cp); } } while (0)
    if ((int)blockIdx.x < T / 16) CONV_LOAD(vn, (int)blockIdx.x);
    for (int it = blockIdx.x; it < T / 16; it += gridDim.x) {
        const int t0 = it * 16 + th * 8, tb = t0 & (SEQ - 1);
        f32x2v av[8];
#pragma unroll
        for (int t = 0; t < 8; ++t) av[t] = bias;
        unsigned vv[38];
#pragma unroll
        for (int r = 0; r < 38; ++r) vv[r] = vn[r];
        if (it + (int)gridDim.x < T / 16) CONV_LOAD(vn, it + (int)gridDim.x);
#pragma unroll
        for (int r = 0; r < 38; ++r) {
            const unsigned v = (tb - 30 + r >= 0) ? vv[r] : 0u;
            const f32x2v vf = {bf_lo(v), bf_hi(v)};
#pragma unroll
            for (int t = 0; t < 8; ++t) { const int k = r - t; if (k >= 0 && k < TAPS) av[t] = __builtin_elementwise_fma(wk[k], vf, av[t]); }
        }
#pragma unroll
        for (int t = 0; t < 8; ++t) *(LAS f32x2v*)(ybuf + (th * 8 + t) * CONVC + 2 * cp) = av[t];
        __syncthreads();
        {   f32x4 y0[2], y1[2]; float sm[2], sq[2];
#pragma unroll
            for (int q = 0; q < 2; ++q) { const LAS float* yr = ybuf + (wave * 2 + q) * CONVC + lane * 8; y0[q] = *(const LAS f32x4*)yr; y1[q] = *(const LAS f32x4*)(yr + 4);
                sm[q] = (y0[q].x + y0[q].y) + (y0[q].z + y0[q].w) + (y1[q].x + y1[q].y) + (y1[q].z + y1[q].w);
                sq[q] = (y0[q].x * y0[q].x + y0[q].y * y0[q].y) + (y0[q].z * y0[q].z + y0[q].w * y0[q].w) + (y1[q].x * y1[q].x + y1[q].y * y1[q].y) + (y1[q].z * y1[q].z + y1[q].w * y1[q].w); }
#pragma unroll
            for (int o = 1; o < 64; o <<= 1) { const float a0 = __shfl_xor(sm[0], o), a1 = __shfl_xor(sq[0], o), a2 = __shfl_xor(sm[1], o), a3 = __shfl_xor(sq[1], o); sm[0] += a0; sq[0] += a1; sm[1] += a2; sq[1] += a3; }
            const f32x4 g0 = *(const f32x4*)(lng + lane * 8), g1 = *(const f32x4*)(lng + lane * 8 + 4), b0 = *(const f32x4*)(lnb + lane * 8), b1 = *(const f32x4*)(lnb + lane * 8 + 4);
#pragma unroll
            for (int q = 0; q < 2; ++q) { const float mu = sm[q] * (1.f / CONVC); const float var = fmaxf(sq[q] * (1.f / CONVC) - mu * mu, 0.f);
                const float rs = 1.0f / sqrtf(var + 1e-5f);
                const f32x4 z0 = (y0[q] - mu) * rs * g0 + b0, z1 = (y1[q] - mu) * rs * g1 + b1;
                u32x4 w; w.x = cvt_pk_bf16(fast_silu(z0.x), fast_silu(z0.y)); w.y = cvt_pk_bf16(fast_silu(z0.z), fast_silu(z0.w)); w.z = cvt_pk_bf16(fast_silu(z1.x), fast_silu(z1.y)); w.w = cvt_pk_bf16(fast_silu(z1.z), fast_silu(z1.w));
                *(u32x4*)(CAT + (size_t)(it * 16 + wave * 2 + q) * D + lane * 8) = w; } }
        __syncthreads();
    }
}

constexpr size_t WS_ABAR = 1 * MiB, WS_BBH = 1 * MiB + 65536, WS_BBL = 1 * MiB + 262144;
constexpr size_t WS_CMH = 1 * MiB + 393216, WS_CML = 1 * MiB + 589824;
constexpr int TSTR = 132;
__device__ __forceinline__ void ssm_tables(int idx, const float* a_re, const float* a_im, const float* b_re, const float* b_im, const float* log_dt, float* ABAR, bf16_t* BBH, bf16_t* BBL) {
    const int g = idx >> 6, p = idx & 63;
    const float dt = expf(log_dt[g]), are = a_re[idx], aim = a_im[idx];
    const float mag = expf(dt * are), ang = dt * aim, ar = mag * cosf(ang), ai = mag * sinf(ang);
    ABAR[2 * idx] = ar; ABAR[2 * idx + 1] = ai;
    const float den = are * are + aim * aim, nr = ar - 1.f, ni = ai;
    const float qr = (nr * are + ni * aim) / den, qi = (ni * are - nr * aim) / den;
    const float* pbr = b_re + (size_t)idx * 16; const float* pbi = b_im + (size_t)idx * 16;
#pragma unroll
    for (int h8 = 0; h8 < 2; ++h8) { float vr[8], vi[8];
#pragma unroll
        for (int e = 0; e < 8; ++e) { const float r = pbr[8 * h8 + e], i = pbi[8 * h8 + e]; vr[e] = qr * r - qi * i; vi[e] = qr * i + qi * r; }
        u32x4 hr, lr, hi, li;
#pragma unroll
        for (int e = 0; e < 4; ++e) { const unsigned a = cvt_pk_bf16(vr[2 * e], vr[2 * e + 1]); hr[e] = a; lr[e] = cvt_pk_bf16(vr[2 * e] - bf_lo(a), vr[2 * e + 1] - bf_hi(a));
            const unsigned c = cvt_pk_bf16(vi[2 * e], vi[2 * e + 1]); hi[e] = c; li[e] = cvt_pk_bf16(vi[2 * e] - bf_lo(c), vi[2 * e + 1] - bf_hi(c)); }
        *(u32x4*)(BBH + ((size_t)(g * 128 + p) * 16 + 8 * h8)) = hr; *(u32x4*)(BBL + ((size_t)(g * 128 + p) * 16 + 8 * h8)) = lr;
        *(u32x4*)(BBH + ((size_t)(g * 128 + 64 + p) * 16 + 8 * h8)) = hi; *(u32x4*)(BBL + ((size_t)(g * 128 + 64 + p) * 16 + 8 * h8)) = li; }
}
__device__ __forceinline__ void ssm_ctable(int idx, const float* c_re, const float* c_im, bf16_t* CMH, bf16_t* CML) {
    const int gh = idx >> 4, c8 = idx & 15; const float* src = (c8 < 8 ? c_re : c_im) + (size_t)gh * NS + (c8 & 7) * 8; const float sg = c8 < 8 ? 1.f : -1.f;
    const f32x4 a = *(const f32x4*)src * sg, b = *(const f32x4*)(src + 4) * sg;
    u32x4 h, l;
    h.x = cvt_pk_bf16(a[0], a[1]); h.y = cvt_pk_bf16(a[2], a[3]); h.z = cvt_pk_bf16(b[0], b[1]); h.w = cvt_pk_bf16(b[2], b[3]);
    l.x = cvt_pk_bf16(a[0] - bf_lo(h.x), a[1] - bf_hi(h.x)); l.y = cvt_pk_bf16(a[2] - bf_lo(h.y), a[3] - bf_hi(h.y)); l.z = cvt_pk_bf16(b[0] - bf_lo(h.z), b[1] - bf_hi(h.z)); l.w = cvt_pk_bf16(b[2] - bf_lo(h.w), b[3] - bf_hi(h.w));
    *(u32x4*)(CMH + (size_t)gh * 128 + c8 * 8) = h; *(u32x4*)(CML + (size_t)gh * 128 + c8 * 8) = l;
}
struct SsmOps { bf16x8 bh[8]; float ar, ai; };
__device__ __forceinline__ void ssm_ops_load(SsmOps& S, const float* ABAR, const bf16_t* BBH, const bf16_t* BBL, int g, int lane) {
    const int fr = lane & 15, fq = lane >> 4; const bf16x8 z = {0, 0, 0, 0, 0, 0, 0, 0};
#pragma unroll
    for (int nb = 0; nb < 8; ++nb) { const size_t o = (size_t)(g * 128 + 16 * nb + fr) * 16 + (fq & 1) * 8;
        const bf16x8 h = *(const bf16x8*)(BBH + o); S.bh[nb] = fq < 2 ? h : z; }
    S.ar = ABAR[2 * (g * 64 + lane)]; S.ai = ABAR[2 * (g * 64 + lane) + 1];
}
__device__ __forceinline__ void ssm_u_load(bf16x8& uh, const bf16_t* US, int tok, int g, int lane) {
    uh = *(const bf16x8*)(US + (size_t)(tok + (lane & 15)) * SSMW + g * 16 + ((lane >> 4) & 1) * 8);
}
__device__ __forceinline__ void ssm_bu_tile(const SsmOps& S, bf16x8 uh, LAS float* tile, int lane) {
    const int fr = lane & 15, fq = lane >> 4;
    if (fq >= 2) uh = (bf16x8){0, 0, 0, 0, 0, 0, 0, 0};
#pragma unroll
    for (int nb = 0; nb < 8; ++nb) { f32x4 acc = {0.f, 0.f, 0.f, 0.f};
        acc = __builtin_amdgcn_mfma_f32_16x16x32_bf16(S.bh[nb], uh, acc, 0, 0, 0);
        *(LAS f32x4*)(tile + fr * TSTR + 16 * nb + 4 * fq) = acc; }
    asm volatile("s_waitcnt lgkmcnt(0)" ::: "memory");
}
__device__ __forceinline__ void ssm_pass1(LAS unsigned char* lds, const bf16_t* US, float* SST, const float* ABAR, const bf16_t* BBH, const bf16_t* BBL, int gw, int NGW, int lane, int wave) {
    LAS float* tile = (LAS float*)(lds + 32768 + wave * (16 * TSTR * 4));
    for (int idx = gw; idx < NB * NG * 7; idx += NGW) {
        const int c = idx % 7, bg = idx / 7, b = bg >> 5, g = bg & 31;
        SsmOps S; ssm_ops_load(S, ABAR, BBH, BBL, g, lane);
        float xr = 0.f, xi = 0.f; const int tokc = b * SEQ + c * 256;
        bf16x8 uh; ssm_u_load(uh, US, tokc, g, lane);
        for (int grp = 0; grp < 16; ++grp) {
            ssm_bu_tile(S, uh, tile, lane);
            if (grp < 15) ssm_u_load(uh, US, tokc + (grp + 1) * 16, g, lane);
            float br[16], bi[16];
#pragma unroll
            for (int t = 0; t < 16; ++t) { br[t] = tile[t * TSTR + lane]; bi[t] = tile[t * TSTR + 64 + lane]; }
            asm volatile("s_waitcnt lgkmcnt(0)" ::: "memory");
#pragma unroll
            for (int t = 0; t < 16; ++t) { const float nr = S.ar * xr - S.ai * xi + br[t], ni = S.ar * xi + S.ai * xr + bi[t]; xr = nr; xi = ni; }
        }
        float* so = SST + ((size_t)bg * 8 + c) * 128; so[lane] = xr; so[64 + lane] = xi;
    }
}
__device__ __forceinline__ void ssm_pass2(LAS unsigned char* lds, const bf16_t* US, const float* SST, bf16_t* YB, const float* ABAR, const bf16_t* BBH, const bf16_t* BBL, const bf16_t* CMH, const bf16_t* CML, const float* dco, int gw, int NGW, int lane, int wave) {
    LAS float* tile = (LAS float*)(lds + wave * (16 * TSTR * 4));
    const int fr = lane & 15, fq = lane >> 4;
    for (int idx = gw; idx < NB * NG * 8; idx += NGW) {
        const int c = idx & 7, bg = idx >> 3, b = bg >> 5, g = bg & 31;
        SsmOps S; ssm_ops_load(S, ABAR, BBH, BBL, g, lane);
        bf16x8 ch[4];
#pragma unroll
        for (int ks = 0; ks < 4; ++ks) { const size_t o = (size_t)(g * 16 + fr) * 128 + ks * 32 + fq * 8; ch[ks] = *(const bf16x8*)(CMH + o); }
        const float dh = dco[g * 16 + fr];
        float pr = S.ar, pi = S.ai;
#pragma unroll
        for (int s = 0; s < 8; ++s) { const float nr = pr * pr - pi * pi, ni = 2.f * pr * pi; pr = nr; pi = ni; }
        float xr = 0.f, xi = 0.f;
        { float sr[7], sm[7];
#pragma unroll
          for (int cc = 0; cc < 7; ++cc) { const float* si = SST + ((size_t)bg * 8 + (cc < c ? cc : 0)) * 128; sr[cc] = si[lane]; sm[cc] = si[64 + lane]; }
#pragma unroll
          for (int cc = 0; cc < 7; ++cc) if (cc < c) { const float nr = pr * xr - pi * xi + sr[cc], ni = pr * xi + pi * xr + sm[cc]; xr = nr; xi = ni; } }
        const int tokc = b * SEQ + c * 256;
        bf16x8 uh; ssm_u_load(uh, US, tokc, g, lane);
        for (int grp = 0; grp < 16; ++grp) { const int tok = tokc + grp * 16;
            ssm_bu_tile(S, uh, tile, lane);
            if (grp < 15) ssm_u_load(uh, US, tok + 16, g, lane);
            float ud[4];
#pragma unroll
            for (int i = 0; i < 4; ++i) ud[i] = bf_lo((unsigned)US[(size_t)(tok + 4 * fq + i) * SSMW + g * 16 + fr]);
            float br[16], bi[16];
#pragma unroll
            for (int t = 0; t < 16; ++t) { br[t] = tile[t * TSTR + lane]; bi[t] = tile[t * TSTR + 64 + lane]; }
            asm volatile("s_waitcnt lgkmcnt(0)" ::: "memory");
#pragma unroll
            for (int t = 0; t < 16; ++t) { const float nr = S.ar * xr - S.ai * xi + br[t], ni = S.ar * xi + S.ai * xr + bi[t]; xr = nr; xi = ni; br[t] = xr; bi[t] = xi; }
#pragma unroll
            for (int t = 0; t < 16; ++t) { tile[t * TSTR + lane] = br[t]; tile[t * TSTR + 64 + lane] = bi[t]; }
            asm volatile("s_waitcnt lgkmcnt(0)" ::: "memory");
            f32x4 acc = {0.f, 0.f, 0.f, 0.f}, acc2 = {0.f, 0.f, 0.f, 0.f};
            f32x4 xa[4][2];
#pragma unroll
            for (int ks = 0; ks < 4; ++ks) { xa[ks][0] = *(const LAS f32x4*)(tile + fr * TSTR + ks * 32 + fq * 8); xa[ks][1] = *(const LAS f32x4*)(tile + fr * TSTR + ks * 32 + fq * 8 + 4); }
#pragma unroll
            for (int ks = 0; ks < 4; ++ks) { const f32x4 x0 = xa[ks][0], x1 = xa[ks][1]; u32x4 h;
                h.x = cvt_pk_bf16(x0[0], x0[1]); h.y = cvt_pk_bf16(x0[2], x0[3]); h.z = cvt_pk_bf16(x1[0], x1[1]); h.w = cvt_pk_bf16(x1[2], x1[3]);
                const bf16x8 xh = __builtin_bit_cast(bf16x8, h);
                if (ks & 1) acc2 = __builtin_amdgcn_mfma_f32_16x16x32_bf16(xh, ch[ks], acc2, 0, 0, 0); else acc = __builtin_amdgcn_mfma_f32_16x16x32_bf16(xh, ch[ks], acc, 0, 0, 0); }
            acc = acc + acc2;
#pragma unroll
            for (int i = 0; i < 4; ++i) { const float y = acc[i] + dh * ud[i];
                const unsigned w = cvt_pk_bf16(gelu_tanh(y), 0.f); YB[(size_t)(tok + 4 * fq + i) * SSMW + g * 16 + fr] = (bf16_t)(w & 0xffffu); }
            asm volatile("s_waitcnt lgkmcnt(0)" ::: "memory");
        }
    }
}

__device__ __forceinline__ void kmean_phase(LAS unsigned char* lds, const bf16_t* QK, float* KM, int tid) {
    const int cp = tid & 255, rh = tid >> 8; LAS float* red = (LAS float*)lds;
    for (int it = blockIdx.x; it < 256; it += gridDim.x) { const int b = it >> 4, n = (it >> 1) & 7, ch = it & 1;
        const bf16_t* p = QK + (size_t)(b * SEQ + n * 256 + rh * 128) * 2048 + 1024 + ch * 512 + 2 * cp; float s0 = 0.f, s1 = 0.f;
#pragma unroll 8
        for (int r = 0; r < 128; ++r) { const unsigned v = *(const unsigned*)(p + (size_t)r * 2048); s0 += bf_lo(v); s1 += bf_hi(v); }
        if (rh == 1) { red[2 * cp] = s0; red[2 * cp + 1] = s1; }
        __syncthreads();
        if (rh == 0) { s0 += red[2 * cp]; s1 += red[2 * cp + 1]; const int col = ch * 512 + 2 * cp, hh = col >> 7, d = col & 127;
            f32x2v o; o.x = s0 * (1.f / 256.f); o.y = s1 * (1.f / 256.f); *(f32x2v*)(KM + ((size_t)(b * NH + hh) * 8 + n) * HD + d) = o; }
        __syncthreads();
    }
}

__device__ __forceinline__ float max3f(float a, float b, float c) { float r; asm("v_max3_f32 %0, %1, %2, %3" : "=v"(r) : "v"(a), "v"(b), "v"(c)); return r; }
constexpr int ATT_KROW = 272, ATT_VROW = 144, ATT_KB = 64 * ATT_KROW, ATT_VB = 128 * ATT_VROW, ATT_STAGE = ATT_KB + ATT_VB;
__device__ __forceinline__ void attn_unit(LAS unsigned char* lds, const bf16_t* QK, const bf16_t* VTt, const float* KM, bf16_t* OA, int b, int h, int qb, int tid, int lane, int wave) {
    const int r32 = lane & 31, hf = lane >> 5;
    const int row0 = b * SEQ + qb * 256 + wave * 32;
    const char* kg = (const char*)(QK + (size_t)(b * SEQ) * 2048 + 1024 + h * HD);
    const char* vg = (const char*)(VTt + (size_t)((b * NH + h) * 32) * 8192);
    unsigned goff[5];
#pragma unroll
    for (int j = 0; j < 5; ++j) { int p = wave + 8 * j; p = p > 34 ? 34 : p; const int off = p * 1024 + lane * 16;
        if (p < 17) { const int r = off / ATT_KROW, cb = off % ATT_KROW; goff[j] = (unsigned)(r * 4096 + (cb < 256 ? cb : 0)); }
        else { const int o2 = off - ATT_KB, d = o2 / ATT_VROW, cb = o2 % ATT_VROW; goff[j] = (unsigned)(d * 128 + (cb < 128 ? cb : 0)); } }
    const int ntiles = 4 * (qb + 1);
#define ATT_DMA(i_, st_) do { const int key0_ = (qb - ((i_) >> 2)) * 256 + ((i_) & 3) * 64; const char* kb_ = kg + (size_t)key0_ * 4096; const char* vb_ = vg + (size_t)(key0_ >> 6) * 16384; \
        _Pragma("unroll") for (int j_ = 0; j_ < 5; ++j_) { int p_ = wave + 8 * j_; p_ = p_ > 34 ? 34 : p_; \
            __builtin_amdgcn_global_load_lds((const unsigned*)((p_ < 17 ? kb_ : vb_) + goff[j_]), (LAS unsigned*)(lds + (st_) * ATT_STAGE + p_ * 1024), 16, 0, 0); } } while (0)
    ATT_DMA(0, 0); ATT_DMA(1, 1);
    bf16x8 qf[8];
    { const bf16_t* qp = QK + (size_t)(row0 + r32) * 2048 + h * HD + hf * 8;
#pragma unroll
      for (int ks = 0; ks < 8; ++ks) qf[ks] = *(const bf16x8*)(qp + ks * 16); }
    unsigned sel = (1u << qb) - 1u;
    if (qb > 3) {
        float gate[7];
#pragma unroll
        for (int n = 0; n < 7; ++n) { gate[n] = -INFINITY;
            if (n < qb) { const float* kp = KM + ((size_t)(b * NH + h) * 8 + n) * HD + hf * 8; float s = 0.f;
#pragma unroll
                for (int ks = 0; ks < 8; ++ks) { const f32x4 k0 = *(const f32x4*)(kp + ks * 16), k1 = *(const f32x4*)(kp + ks * 16 + 4); const u32x4 q = __builtin_bit_cast(u32x4, qf[ks]);
                    s += bf_lo(q.x) * k0.x + bf_hi(q.x) * k0.y + bf_lo(q.y) * k0.z + bf_hi(q.y) * k0.w + bf_lo(q.z) * k1.x + bf_hi(q.z) * k1.y + bf_lo(q.w) * k1.z + bf_hi(q.w) * k1.w; }
                gate[n] = s + __shfl_xor(s, 32); } }
        sel = 0u;
#pragma unroll
        for (int rnd = 0; rnd < 3; ++rnd) { float best = -INFINITY; int bi = 0;
#pragma unroll
            for (int n = 0; n < 7; ++n) { const bool ok = (n < qb) && !((sel >> n) & 1u) && (gate[n] > best); best = ok ? gate[n] : best; bi = ok ? n : bi; }
            sel |= 1u << bi; }
    }
    f32x16 o[4];
#pragma unroll
    for (int db = 0; db < 4; ++db)
#pragma unroll
        for (int i = 0; i < 16; ++i) o[db][i] = 0.f;
    float mrun = -1e30f, lrun = 0.f;
    const int pi_r = ((r32 >> 2) & 1) * 16 + (r32 >> 3) * 4 + (r32 & 3);
    const int qq = wave * 32 + r32;
    const unsigned kread = pi_r * ATT_KROW + hf * 16, vread = ATT_KB + r32 * ATT_VROW + hf * 32;
    asm volatile("s_waitcnt vmcnt(0)" ::: "memory"); __builtin_amdgcn_s_barrier(); asm volatile("" ::: "memory");
    int st = 0;
    for (int i = 0; i < ntiles; ++i) {
        if (!(i & 1) && i + 2 < ntiles) { ATT_DMA(i + 2, (st + 2) & 3); ATT_DMA(i + 3, (st + 3) & 3); }
        const int kb = qb - (i >> 2), t = i & 3; const bool own = (kb == qb); const bool on = own || ((sel >> kb) & 1u);
        const bool active = own ? (64 * t <= wave * 32 + 31) : (__ballot(on) != 0ull);
        if (active) {
            const LAS unsigned char* sb = lds + st * ATT_STAGE;
            f32x16 s0, s1;
#pragma unroll
            for (int e = 0; e < 16; ++e) { s0[e] = 0.f; s1[e] = 0.f; }
            bf16x8 fa[8], fb[8];
#pragma unroll
            for (int ks = 0; ks < 8; ++ks) fa[ks] = *(const LAS bf16x8*)(sb + kread + ks * 32);
#pragma unroll
            for (int ks = 0; ks < 8; ++ks) fb[ks] = *(const LAS bf16x8*)(sb + kread + 32 * ATT_KROW + ks * 32);
            __builtin_amdgcn_sched_barrier(0);
#pragma unroll
            for (int ks = 0; ks < 8; ++ks) s0 = __builtin_amdgcn_mfma_f32_32x32x16_bf16(fa[ks], qf[ks], s0, 0, 0, 0);
            __builtin_amdgcn_sched_barrier(0);
#pragma unroll
            for (int db = 0; db < 4; ++db)
#pragma unroll
                for (int s2 = 0; s2 < 2; ++s2) fa[db * 2 + s2] = *(const LAS bf16x8*)(sb + vread + db * 32 * ATT_VROW + s2 * 16);
#pragma unroll
            for (int ks = 0; ks < 8; ++ks) s1 = __builtin_amdgcn_mfma_f32_32x32x16_bf16(fb[ks], qf[ks], s1, 0, 0, 0);
            __builtin_amdgcn_sched_barrier(0);
#pragma unroll
            for (int db = 0; db < 4; ++db)
#pragma unroll
                for (int s2 = 0; s2 < 2; ++s2) fb[db * 2 + s2] = *(const LAS bf16x8*)(sb + vread + db * 32 * ATT_VROW + 64 + s2 * 16);
            if (own && (64 * t + 63 > wave * 32)) {
                const int kk0 = t * 64 + hf * 16;
#pragma unroll
                for (int e = 0; e < 16; ++e) { s0[e] = (kk0 + e <= qq) ? s0[e] : -INFINITY; s1[e] = (kk0 + 32 + e <= qq) ? s1[e] : -INFINITY; }
            }
            float mxa = max3f(s0[0], s0[1], s1[0]), mxb = max3f(s0[2], s0[3], s1[1]); mxa = max3f(mxa, s1[2], s1[3]);
#pragma unroll
            for (int e = 4; e < 16; e += 4) { mxa = max3f(mxa, s0[e], s0[e + 1]); mxb = max3f(mxb, s0[e + 2], s0[e + 3]); mxa = max3f(mxa, s1[e], s1[e + 1]); mxb = max3f(mxb, s1[e + 2], s1[e + 3]); }
            float mx = on ? max3f(mxa, mxb, mxb) : -INFINITY;
            { const auto rr = __builtin_amdgcn_permlane32_swap(__builtin_bit_cast(unsigned, mx), __builtin_bit_cast(unsigned, mx), false, false);
              mx = fmaxf(__builtin_bit_cast(float, rr[0]), __builtin_bit_cast(float, rr[1])); }
            float alpha = 1.f;
            if (__ballot(mx > mrun + 8.f) != 0ull) { const float mnew = fmaxf(mrun, mx); alpha = __builtin_amdgcn_exp2f(mrun - mnew); mrun = mnew;
#pragma unroll
                for (int db = 0; db < 4; ++db)
#pragma unroll
                    for (int e = 0; e < 16; ++e) o[db][e] *= alpha; }
            const float msub = on ? mrun : INFINITY;
            float ps = 0.f;
#pragma unroll
            for (int e = 0; e < 16; ++e) { s0[e] = __builtin_amdgcn_exp2f(s0[e] - msub); s1[e] = __builtin_amdgcn_exp2f(s1[e] - msub); ps += s0[e] + s1[e]; }
            lrun = lrun * alpha + ps;
            bf16x8 pf[2][2];
#pragma unroll
            for (int s2 = 0; s2 < 2; ++s2) { u32x4 w; w.x = cvt_pk_bf16(s0[8 * s2 + 0], s0[8 * s2 + 1]); w.y = cvt_pk_bf16(s0[8 * s2 + 2], s0[8 * s2 + 3]); w.z = cvt_pk_bf16(s0[8 * s2 + 4], s0[8 * s2 + 5]); w.w = cvt_pk_bf16(s0[8 * s2 + 6], s0[8 * s2 + 7]); pf[0][s2] = __builtin_bit_cast(bf16x8, w);
                u32x4 v; v.x = cvt_pk_bf16(s1[8 * s2 + 0], s1[8 * s2 + 1]); v.y = cvt_pk_bf16(s1[8 * s2 + 2], s1[8 * s2 + 3]); v.z = cvt_pk_bf16(s1[8 * s2 + 4], s1[8 * s2 + 5]); v.w = cvt_pk_bf16(s1[8 * s2 + 6], s1[8 * s2 + 7]); pf[1][s2] = __builtin_bit_cast(bf16x8, v); }
            __builtin_amdgcn_sched_barrier(0);
#pragma unroll
            for (int s2 = 0; s2 < 2; ++s2)
#pragma unroll
                for (int db = 0; db < 4; ++db) o[db] = __builtin_amdgcn_mfma_f32_32x32x16_bf16(fa[db * 2 + s2], pf[0][s2], o[db], 0, 0, 0);
#pragma unroll
            for (int s2 = 0; s2 < 2; ++s2)
#pragma unroll
                for (int db = 0; db < 4; ++db) o[db] = __builtin_amdgcn_mfma_f32_32x32x16_bf16(fb[db * 2 + s2], pf[1][s2], o[db], 0, 0, 0);
        }
        if (i & 1) { asm volatile("s_waitcnt vmcnt(0)" ::: "memory");
            asm volatile("s_waitcnt lgkmcnt(0)" ::: "memory"); __builtin_amdgcn_s_barrier(); asm volatile("" ::: "memory"); }
        st = (st + 1) & 3;
    }
#undef ATT_DMA
    const float inv = 1.f / (lrun + __shfl_xor(lrun, 32));
    bf16_t* op = OA + (size_t)(row0 + r32) * D + h * HD + hf * 4;
#pragma unroll
    for (int db = 0; db < 4; ++db)
#pragma unroll
        for (int rg = 0; rg < 4; ++rg) { u32x2 w; w.x = cvt_pk_bf16(o[db][4 * rg] * inv, o[db][4 * rg + 1] * inv); w.y = cvt_pk_bf16(o[db][4 * rg + 2] * inv, o[db][4 * rg + 3] * inv);
            *(u32x2*)(op + db * 32 + rg * 8) = w; }
}

#define XB_TMO      128
#define XB_XCNT(j)  (256  + 64 * (j))
#define XB_XSUB(j)  (1280 + 64 * (j))
#define XB_XGEN(j)  (2304 + 64 * (j))
#define XB_TOP      3328
#define XB_TOPGEN   3392
#define XCD_BAR_WORDS 3456
#define XB_SPIN_CAP (1u << 18)

__device__ __forceinline__ unsigned xb_ld(unsigned* p)              { return __hip_atomic_load(p, __ATOMIC_RELAXED, __HIP_MEMORY_SCOPE_AGENT); }
__device__ __forceinline__ unsigned xb_add(unsigned* p, unsigned v) { return __hip_atomic_fetch_add(p, v, __ATOMIC_RELAXED, __HIP_MEMORY_SCOPE_AGENT); }
__device__ __forceinline__ unsigned xb_xcc_id() { return (unsigned)__builtin_amdgcn_s_getreg((3 << 11) | 20) & 0xFu; }
#define XB_SPIN(cond, bar) do { unsigned _sp = 0; while (cond) { __builtin_amdgcn_s_sleep(1); \
    if ((++_sp & 255u) == 0u) { if (xb_ld(&(bar)[XB_TMO])) break; if (_sp > XB_SPIN_CAP) { atomicAdd(&(bar)[XB_TMO], 1u); break; } } } } while (0)

struct XcdBarrier {
    unsigned* bar; unsigned x;
    volatile LAS unsigned* st;
};

__device__ __forceinline__ XcdBarrier xcd_barrier_post(unsigned* bar, volatile LAS unsigned* st) {
    XcdBarrier b; b.bar = bar; b.x = xb_xcc_id(); b.st = st;
    if (threadIdx.x == 0) (void)xb_add(&bar[XB_XCNT(b.x)], 1u);
    return b;
}
__device__ __forceinline__ void xcd_barrier_complete(unsigned* bar, unsigned x, unsigned& nloc, unsigned& nx) {
    const unsigned G = gridDim.x * gridDim.y * gridDim.z;
    unsigned sum, cnt, mine, sp = 0u;
    for (;;) {
        sum = 0u; cnt = 0u; mine = 0u;
#pragma unroll
        for (unsigned j = 0; j < 16; ++j) { const unsigned c = xb_ld(&bar[XB_XCNT(j)]); sum += c; cnt += (c > 0u) ? 1u : 0u; mine = (j == x) ? c : mine; }
        if (sum == G) break;
        __builtin_amdgcn_s_sleep(1);
        if ((++sp & 255u) == 0u) { if (xb_ld(&bar[XB_TMO])) break; if (sp > XB_SPIN_CAP) { atomicAdd(&bar[XB_TMO], 1u); break; } }
    }
    nloc = mine > 0u ? mine : 1u; nx = cnt > 0u ? cnt : 1u;
}

__device__ __forceinline__ void xcd_barrier(const XcdBarrier& b) {
    asm volatile("s_waitcnt vmcnt(0)" ::: "memory");
    __syncthreads();
    if (threadIdx.x == 0) {
        unsigned* bar = b.bar;
        __builtin_amdgcn_s_waitcnt(0);
        unsigned nloc = b.st[0], nx = b.st[1];
        if (nloc == 0u) { xcd_barrier_complete(bar, b.x, nloc, nx); b.st[0] = nloc; b.st[1] = nx; }
        const unsigned old = xb_add(&bar[XB_XSUB(b.x)], 1u);
        const unsigned gen = old / nloc;
        if (old + 1u == (gen + 1u) * nloc) {
            __builtin_amdgcn_fence(__ATOMIC_RELEASE, "agent");
            asm volatile("s_waitcnt vmcnt(0)" ::: "memory");
            const unsigned og = xb_add(&bar[XB_TOP], 1u);
            const unsigned tg = og / nx;
            if (og + 1u == (tg + 1u) * nx) xb_add(&bar[XB_TOPGEN], 1u);
            else XB_SPIN(xb_ld(&bar[XB_TOPGEN]) == tg, bar);
            __builtin_amdgcn_fence(__ATOMIC_ACQUIRE, "agent");
            xb_add(&bar[XB_XGEN(b.x)], 1u);
            asm volatile("s_waitcnt vmcnt(0)" ::: "memory");
        } else {
            XB_SPIN(xb_ld(&bar[XB_XGEN(b.x)]) == gen, bar);
            __builtin_amdgcn_fence(__ATOMIC_ACQUIRE, "agent");
            asm volatile("s_waitcnt vmcnt(0)" ::: "memory");
        }
    }
    __syncthreads();
}

constexpr size_t WS_CTL = 1 * MiB + 524288;
constexpr int LDS_ST_OFF = LDS_BYTES - 64;
template <bool WANT_PN> __device__ __forceinline__ int unit_tile(int M, int N, int G, int c, int i) {
    const int nM = M / 256, nN = N / 256, nwg = nM * nN; const long L = (long)i * G + c; if (L >= nwg) return -1;
    int wgid = (int)L; { const int q = nwg / pg8::NXCD, r = nwg % pg8::NXCD, xcd = wgid % pg8::NXCD, off = wgid / pg8::NXCD; wgid = (xcd < r ? xcd * (q + 1) : r * (q + 1) + (xcd - r) * q) + off; }
    const int nig = pg8::WGM * nN, gid = wgid / nig, fm = gid * pg8::WGM, gsz = (nM - fm) < pg8::WGM ? (nM - fm) : pg8::WGM;
    return WANT_PN ? (wgid % nig) / gsz : fm + ((wgid % nig) % gsz);
}
struct Args { const float* in[25]; float* out; unsigned char* ws; int ph_lo, ph_hi; };
constexpr int N_PHASES = 19;

template <class Epi> __device__ __forceinline__ void run_gemm(LAS unsigned char* lds, const bf16_t* A, const bf16_t* Bt, int M, int N, int K, const Epi& E) {
    pg8::Gemm g{A, Bt, M, N, K}; pg8::StaticOrder S; S.init(M, N, (int)gridDim.x, (int)blockIdx.x);
    pg8::gemm_phase<Epi, pg8::StaticOrder, true, true>(lds, g, S, E);
}

__global__ void __launch_bounds__(NTHREADS, 2) mega_fwd(Args a) {
    extern __shared__ __attribute__((aligned(16))) unsigned char lds_raw[];
    LAS unsigned char* lds = (LAS unsigned char*)lds_raw;
    cg::grid_group grid = cg::this_grid();
    const int tid = threadIdx.x, lane = tid & 63, wave = __builtin_amdgcn_readfirstlane(tid >> 6);
    const int G = gridDim.x, gw = blockIdx.x * NWAVES + wave, NGW = G * NWAVES;
    unsigned char* ws = a.ws;
    bf16_t* XB = (bf16_t*)(ws + WS_H); bf16_t* U = (bf16_t*)(ws + WS_U);
    bf16_t* VC = (bf16_t*)(ws + WS_VC); bf16_t* US = (bf16_t*)(ws + WS_US); bf16_t* YB = (bf16_t*)(ws + WS_YB); bf16_t* CAT = (bf16_t*)(ws + WS_CAT);
    bf16_t* QK = (bf16_t*)(ws + WS_QK); bf16_t* VT = (bf16_t*)(ws + WS_VT); bf16_t* OA = (bf16_t*)(ws + WS_OA);
    float* KM = (float*)(ws + WS_KMEAN); float* SST = (float*)(ws + WS_SST); float* SS = (float*)(ws + WS_SS);
    const int lo = a.ph_lo, hi = a.ph_hi;
    volatile LAS unsigned* bst = (volatile LAS unsigned*)(lds + LDS_ST_OFF);
    if (tid < 2) bst[tid] = 0u;
    __syncthreads();
    XcdBarrier xbar = xcd_barrier_post((unsigned*)(ws + WS_CTL), bst);
#define IN(k) (lo <= (k) && (k) < hi)
#define SEAM(k) do { if (IN(k) && IN((k) + 1)) xcd_barrier(xbar); } while (0)
    if (lo < 0) grid.sync();

    if (IN(0)) {
        LAS float* scr = (LAS float*)(lds + wave * 16384);
        constexpr int I_UP = (D / 64) * (FF / 32), I_DN = (FF / 64) * (D / 32), I_FFN = 2 * I_UP + I_DN;
        constexpr int I_IN = (D / 64) * (512 / 32), I_GLU = (512 / 64) * (512 / 32), I_SQ = (D / 64) * (D / 32), I_QK = (D / 64) * (2048 / 32);
        constexpr int NITEMS = 4 * I_FFN + 3 * I_IN + I_GLU + I_SQ + I_QK + I_SQ + I_SQ;
#define P0_DESC(it_, out_) do { int r = (it_); \
            if (r < 4 * I_FFN) { const int f = r / I_FFN; r -= f * I_FFN; \
                bf16_t* wup = (bf16_t*)(ws + WS_WUP + f * WUP_STRIDE); bf16_t* wdn = (bf16_t*)(ws + WS_WDN + f * WDN_STRIDE); const float* gn = a.in[1] + f * D; \
                if (r < I_UP) out_ = tr_desc(a.in[2] + (size_t)f * D * FF, FF, D, wup, FF / 32, 1, 0, gn, r); \
                else if (r < 2 * I_UP) out_ = tr_desc(a.in[3] + (size_t)f * D * FF, FF, D, wup, FF / 32, 1, 1, gn, r - I_UP); \
                else out_ = tr_desc(a.in[4] + (size_t)f * FF * D, D, FF, wdn, D / 32, 0, 0, nullptr, r - 2 * I_UP); } \
            else { r -= 4 * I_FFN; \
                if (r < I_IN) out_ = tr_desc(a.in[6], 1536, D, (bf16_t*)(ws + WS_WIN), 16, 1, 0, a.in[5], r); \
                else if (r < 2 * I_IN) out_ = tr_desc(a.in[6] + 512, 1536, D, (bf16_t*)(ws + WS_WIN), 16, 1, 1, a.in[5], r - I_IN); \
                else if (r < 3 * I_IN) out_ = tr_desc(a.in[6] + 1024, 1536, D, (bf16_t*)(ws + WS_WIN), 16, 0, 1024, a.in[5], r - 2 * I_IN); \
                else { r -= 3 * I_IN; \
                    if (r < I_GLU) out_ = tr_desc(a.in[19], 512, 512, (bf16_t*)(ws + WS_WGLU), 16, 0, 0, nullptr, r); \
                    else if (r < I_GLU + I_SQ) out_ = tr_desc(a.in[21], D, D, (bf16_t*)(ws + WS_WOUT), 32, 0, 0, nullptr, r - I_GLU); \
                    else if (r < I_GLU + I_SQ + I_QK) out_ = tr_desc(a.in[22], 3072, D, (bf16_t*)(ws + WS_WQK), 64, 0, 0, a.in[5] + D, r - I_GLU - I_SQ); \
                    else if (r < I_GLU + 2 * I_SQ + I_QK) out_ = tr_desc(a.in[22] + 2048, 3072, D, (bf16_t*)(ws + WS_WV), 32, 0, 0, a.in[5] + D, r - I_GLU - I_SQ - I_QK); \
                    else out_ = tr_desc(a.in[23], D, D, (bf16_t*)(ws + WS_WO), 32, 0, 0, nullptr, r - I_GLU - 2 * I_SQ - I_QK); } } } while (0)
        if (gw < NITEMS) {
            TrDesc dc; P0_DESC(gw, dc); float vc[32]; tr_load(dc, vc, lane);
            for (int it = gw; it < NITEMS; it += NGW) {
                TrDesc dn = dc; float vn[32];
                const bool more = it + NGW < NITEMS;
                if (more) { P0_DESC(it + NGW, dn); tr_load(dn, vn, lane); }
                tr_store(dc, vc, scr, lane);
                if (more) { dc = dn;
#pragma unroll
                    for (int i = 0; i < 32; ++i) vc[i] = vn[i]; }
            }
        }
#undef P0_DESC
        if (gw * 64 + lane < NG * NS) ssm_tables(gw * 64 + lane, a.in[11], a.in[12], a.in[13], a.in[14], a.in[18], (float*)(ws + WS_ABAR), (bf16_t*)(ws + WS_BBH), (bf16_t*)(ws + WS_BBL));
        if (gw * 64 + lane < NG * 16 * 16) ssm_ctable(gw * 64 + lane, a.in[15], a.in[16], (bf16_t*)(ws + WS_CMH), (bf16_t*)(ws + WS_CML));
        for (int i = gw * 64 + lane; i < NB * NH * 8 * HD; i += NGW * 64) KM[i] = 0.f;
        xb_rows(a.in[0], XB, SS, gw, NGW, lane);
    }
    SEAM(0);
#define BUILD_RTAB(RT, M_, N_, WANT_PN, nin) RTab RT; { int q0 = -1, q1 = -1, q2 = -1, q3 = -1; \
          for (int i = 0; i < 16; ++i) { const int pm_ = unit_tile<WANT_PN>(M_, N_, G, (int)blockIdx.x, i); if (pm_ >= 0 && pm_ != q0 && pm_ != q1 && pm_ != q2 && pm_ != q3) { if (q0 < 0) q0 = pm_; else if (q1 < 0) q1 = pm_; else if (q2 < 0) q2 = pm_; else if (q3 < 0) q3 = pm_; } } \
          const float* ssp = SS + (nin) * SSN; __syncthreads(); \
          _Pragma("unroll") for (int q = 0; q < 4; ++q) { const int pq = q == 0 ? q0 : (q == 1 ? q1 : (q == 2 ? q2 : q3)); if (pq >= 0 && tid < 256) { const int row = pq * 256 + tid; float t = 0.f; \
              _Pragma("unroll") for (int p = 0; p < 16; ++p) t += ssp[(size_t)p * T + row]; ((LAS float*)(lds + LDS_RTAB_OFF))[q * 256 + tid] = rs_of(t); } } \
          __syncthreads(); RT = RTab{(const LAS float*)(lds + LDS_RTAB_OFF), q0, q1, q2, q3}; }
#define FFN_UP(k, f, nin) if (IN(k)) { BUILD_RTAB(RT, T, 2 * FF, false, nin) EpiSwiglu E{U, RT}; \
        run_gemm(lds, XB, (const bf16_t*)(ws + WS_WUP + (f) * WUP_STRIDE), T, 2 * FF, D, E); } SEAM(k);
#define FFN_DN(k, f, xin, nout) if (IN(k)) { EpiResid E{XB, 0.5f, SS + (nout) * SSN}; run_gemm(lds, U, (const bf16_t*)(ws + WS_WDN + (f) * WDN_STRIDE), T, D, FF, E); } SEAM(k);
    FFN_UP(1, 0, 0)
    FFN_DN(2, 0, a.in[0], 1)
    if (IN(3)) { BUILD_RTAB(RT, T, 1536, false, 1) EpiWin E{VC, US, RT}; run_gemm(lds, XB, (const bf16_t*)(ws + WS_WIN), T, 1536, D, E); }
    SEAM(3);
    if (IN(4)) {
        conv_phase(lds, VC, a.in[7], a.in[8], a.in[9], a.in[10], CAT, tid, lane, wave);
        ssm_pass1(lds, US, SST, (const float*)(ws + WS_ABAR), (const bf16_t*)(ws + WS_BBH), (const bf16_t*)(ws + WS_BBL), gw, NGW, lane, wave);
    }
    SEAM(4);
    if (IN(5)) ssm_pass2(lds, US, SST, YB, (const float*)(ws + WS_ABAR), (const bf16_t*)(ws + WS_BBH), (const bf16_t*)(ws + WS_BBL), (const bf16_t*)(ws + WS_CMH), (const bf16_t*)(ws + WS_CML), a.in[17], gw, NGW, lane, wave);
    SEAM(5);
    if (IN(6)) { EpiGlu E{YB, a.in[20], CAT}; run_gemm(lds, YB, (const bf16_t*)(ws + WS_WGLU), T, 512, 512, E); }
    SEAM(6);
    if (IN(7)) { EpiResid E{XB, 1.f, SS + 2 * SSN}; run_gemm(lds, CAT, (const bf16_t*)(ws + WS_WOUT), T, D, D, E); }
    SEAM(7);
    FFN_UP(8, 1, 2)
    FFN_DN(9, 1, X, 3)
    FFN_UP(10, 2, 3)
    FFN_DN(11, 2, X, 4)
    if (IN(12)) {
        { BUILD_RTAB(RT, T, 2048, false, 4) EpiBf E{QK, 2048, 4, C2, RT, KM}; run_gemm(lds, XB, (const bf16_t*)(ws + WS_WQK), T, 2048, D, E); }
        { BUILD_RTAB(RT, D, T, true, 4) EpiVT E{VT, RT}; run_gemm(lds, (const bf16_t*)(ws + WS_WV), XB, D, T, D, E); }
    }
    SEAM(12);
    if (IN(14)) {
        const int vcu = (G % 8 == 0) ? (int)(blockIdx.x % 8) * (G / 8) + (int)(blockIdx.x / 8) : (int)blockIdx.x;
        for (int pu = vcu; pu < NB * NH * 4; pu += G) { const int bh = pu >> 2, j = pu & 3, b = bh >> 3, h = bh & 7;
            attn_unit(lds, QK, VT, KM, OA, b, h, 7 - j, tid, lane, wave);
            attn_unit(lds, QK, VT, KM, OA, b, h, j, tid, lane, wave); }
    }
    SEAM(14);
    if (IN(15)) { EpiResid E{XB, 1.f, SS + 5 * SSN}; run_gemm(lds, OA, (const bf16_t*)(ws + WS_WO), T, D, D, E); }
    SEAM(15);
    FFN_UP(16, 3, 5)
    FFN_DN(17, 3, X, 6)
    if (IN(18)) final_rows(XB, a.out, a.in[24], SS + 6 * SSN, gw, NGW, lane);
#undef IN
#undef SEAM
}

extern "C" void kernel_launch(void* const* d_in, const int* in_sizes, int n_in, void* d_out, int out_size, void* d_ws, size_t ws_size, hipStream_t stream) {
    static int grid = 0;
    if (grid == 0) {
        if (n_in != 25 || in_sizes[0] != T * D || out_size != T * D || ws_size < WS_END) { fprintf(stderr, "kernel_launch: unexpected shapes (n_in %d, in0 %d, out %d, ws %zu < %zu)\n", n_in, n_in > 0 ? in_sizes[0] : -1, out_size, ws_size, (size_t)WS_END); grid = -1; return; }
        int dev = 0, cus = 0, per_cu = 0;
        (void)hipGetDevice(&dev); (void)hipDeviceGetAttribute(&cus, hipDeviceAttributeMultiprocessorCount, dev);
        if (hipFuncSetAttribute((const void*)mega_fwd, hipFuncAttributeMaxDynamicSharedMemorySize, LDS_BYTES) != hipSuccess) { fprintf(stderr, "kernel_launch: hipFuncSetAttribute failed\n"); grid = -1; return; }
        if (hipOccupancyMaxActiveBlocksPerMultiprocessor(&per_cu, (const void*)mega_fwd, NTHREADS, LDS_BYTES) != hipSuccess || per_cu < 1) { fprintf(stderr, "kernel_launch: occupancy query says %d\n", per_cu); per_cu = 1; }
        (void)hipGetLastError();
        grid = cus * 1;
        fprintf(stderr, "kernel_launch: grid %d (cus %d, per_cu %d)\n", grid, cus, per_cu);
    }
    if (grid < 0) return;
    Args a{};
    for (int i = 0; i < 25; ++i) a.in[i] = (const float*)d_in[i];
    a.out = (float*)d_out; a.ws = (unsigned char*)d_ws; a.ph_lo = 0; a.ph_hi = N_PHASES;
    if (hipMemsetAsync((char*)d_ws + WS_CTL, 0, 16384, stream) != hipSuccess) { fprintf(stderr, "kernel_launch: memset failed\n"); return; }
    void* args[] = {&a};
    hipError_t e = hipLaunchCooperativeKernel((const void*)mega_fwd, dim3(grid), dim3(NTHREADS), args, LDS_BYTES, stream);
    if (e != hipSuccess) fprintf(stderr, "kernel_launch: cooperative launch failed: %s (grid %d)\n", hipGetErrorString(e), grid);
}
```

```cpp
#include <hip/hip_runtime.h>
#include <hip/hip_cooperative_groups.h>
#include <cstdio>
#include <cstdint>
namespace cg = cooperative_groups;
namespace pg8 {
#define PG8_LAS __attribute__((address_space(3)))
typedef unsigned short bf16_t;
typedef short bf16x8 __attribute__((ext_vector_type(8)));
typedef float f32x4 __attribute__((ext_vector_type(4)));
typedef unsigned u32x4 __attribute__((ext_vector_type(4)));
constexpr int BM = 256, BK = 64, HALF = 128, HTB = HALF * BK * 2  , STAGE_BYTES = 8 * HTB, NXCD = 8, WGM = 8;

__host__ __device__ __forceinline__ int lds_byte(int r, int c) { const int st = (r >> 4) * 2 + (c >> 5), rr = r & 15, cc = c & 31, ob = rr * 64 + cc * 2; return st * 1024 + (ob ^ (((ob >> 9) & 1) << 5)); }
__host__ __device__ __forceinline__ void stage_rc(int b, int& R, int& C) { const int st = b / 1024, sb = b % 1024, swz = sb ^ (((sb >> 9) & 1) << 5); R = (st >> 1) * 16 + swz / 64; C = (st & 1) * 32 + (swz % 64) / 2; }
__host__ __device__ __forceinline__ int perm32(int rho) { const int n = rho >> 4, i = rho & 15; return 8 * (i >> 2) + 4 * n + (i & 3); }

struct Unit { int pm, pn; };
struct Gemm { const bf16_t* A; const bf16_t* Bt; int M, N, K; };

struct StaticOrder {
    int nM, nN, nwg, G, c;
    __host__ __device__ void init(int M, int N, int G_, int c_) { nM = M / BM; nN = N / BM; nwg = nM * nN; G = G_; c = c_; }
    __host__ __device__ bool next(int i, Unit& u) const {
        const long L = (long)i * G + c; if (L >= nwg) return false;
        int wgid = (int)L; { const int q = nwg / NXCD, r = nwg % NXCD, xcd = wgid % NXCD, off = wgid / NXCD; wgid = (xcd < r ? xcd * (q + 1) : r * (q + 1) + (xcd - r) * q) + off; }
        const int nig = WGM * nN, gid = wgid / nig, fm = gid * WGM, gsz = (nM - fm) < WGM ? (nM - fm) : WGM;
        u.pm = fm + ((wgid % nig) % gsz); u.pn = (wgid % nig) / gsz; return true;
    }
    __device__ __forceinline__ void a_ready(const Unit&) const {}
    __device__ __forceinline__ void done(const Unit&) const {}
};

__device__ __forceinline__ unsigned cvt_pk_bf16(float lo, float hi) { unsigned r; asm volatile("v_cvt_pk_bf16_f32 %0, %1, %2" : "=v"(r) : "v"(lo), "v"(hi)); return r; }
typedef float f32x2 __attribute__((ext_vector_type(2)));
template <class Epi, class Sched, bool ALIGN_EPI = false, bool SP2 = false>
__device__ __forceinline__ void gemm_phase(PG8_LAS unsigned char* lds, const Gemm g, const Sched& S, const Epi& E) {
    const int tid = threadIdx.x, wid = __builtin_amdgcn_readfirstlane(tid >> 6), lane = tid & 63, wr = wid >> 2, wc = wid & 3, fr = lane & 15, fq = lane >> 4;
    const int K = g.K, nt = K / BK;
    unsigned voffA[2], voffB[2];
#pragma unroll
    for (int i = 0; i < 2; ++i) { int R, C; stage_rc(tid * 16 + i * 8192, R, C); const int Rb = Epi::PERM ? ((R & ~31) + perm32(R & 31)) : R;
        voffA[i] = (unsigned)(R * K + C) * 2u; voffB[i] = (unsigned)(Rb * K + C) * 2u; }
    const size_t kstep = (size_t)(BK * 2);
    const size_t hstep = (size_t)HALF * K * 2;
    const size_t tstep = 2 * hstep;
    const unsigned ldsw = (unsigned)wid * 1024u;
    const int aoff = lds_byte(wr * 64 + fr, fq * 8), boff = lds_byte(wc * 32 + fr, fq * 8);
#define PG8_SA(b, h) (((b) * 2 + (h)) * HTB)
#define PG8_SB(b, h) ((4 + (b) * 2 + (h)) * HTB)
#define PG8_STAGE(bufoff, gbase, voff) do { _Pragma("unroll") for (int _i = 0; _i < 2; ++_i) \
        __builtin_amdgcn_global_load_lds((const unsigned*)((const char*)(gbase) + (voff)[_i]), (PG8_LAS unsigned*)(lds + (bufoff) + ldsw + _i * 8192), 16, 0, 0); } while (0)
#define PG8_LDA(dst, b, h) do { _Pragma("unroll") for (int m = 0; m < 4; ++m) _Pragma("unroll") for (int k = 0; k < 2; ++k) dst[m][k] = *(const PG8_LAS bf16x8*)(lds + PG8_SA(b, h) + aoff + m * 2048 + k * 1024); } while (0)
#define PG8_LDB(dst, b, h) do { _Pragma("unroll") for (int n = 0; n < 2; ++n) _Pragma("unroll") for (int k = 0; k < 2; ++k) dst[n][k] = *(const PG8_LAS bf16x8*)(lds + PG8_SB(b, h) + boff + n * 2048 + k * 1024); } while (0)
#define PG8_MMA(ai, bj, At, Bt) do { __builtin_amdgcn_s_setprio(1); _Pragma("unroll") for (int m = 0; m < 4; ++m) _Pragma("unroll") for (int n = 0; n < 2; ++n) _Pragma("unroll") for (int k = 0; k < 2; ++k) \
        acc[ai][bj][m][n] = __builtin_amdgcn_mfma_f32_16x16x32_bf16(Bt[n][k], At[m][k], acc[ai][bj][m][n], 0, 0, 0); __builtin_amdgcn_s_setprio(0); } while (0)
#define PG8_WAIT_V(n) asm volatile("s_waitcnt vmcnt(" #n ")" ::: "memory")
#define PG8_WAIT_L(n) asm volatile("s_waitcnt lgkmcnt(" #n ")" ::: "memory")
#define PG8_BAR __builtin_amdgcn_s_barrier()
#define PG8_SCHED __builtin_amdgcn_sched_barrier(0)
    Unit cur, nxt; int ui = 0;
    if (!S.next(0, cur)) return;
    f32x4 acc[2][2][4][2];
#pragma unroll
    for (int a = 0; a < 2; ++a)
#pragma unroll
        for (int b = 0; b < 2; ++b)
#pragma unroll
            for (int m = 0; m < 4; ++m)
#pragma unroll
                for (int n = 0; n < 2; ++n) acc[a][b][m][n] = (f32x4){0.f, 0.f, 0.f, 0.f};
    bf16x8 At[4][2], B0[2][2], B1[2][2];
    const char* cA = (const char*)g.A + (size_t)cur.pm * tstep; const char* cB = (const char*)g.Bt + (size_t)cur.pn * tstep;
    S.a_ready(cur);
    if constexpr (SP2) {
        PG8_STAGE(PG8_SB(0, 0), cB, voffB); PG8_STAGE(PG8_SB(0, 1), cB + hstep, voffB); PG8_STAGE(PG8_SA(0, 0), cA, voffA); PG8_STAGE(PG8_SA(0, 1), cA + hstep, voffA);
        if (wr == 1) PG8_BAR;
        PG8_WAIT_V(2); PG8_BAR;
        PG8_STAGE(PG8_SB(1, 0), cB + kstep, voffB); PG8_STAGE(PG8_SA(1, 0), cA + kstep, voffA); PG8_STAGE(PG8_SB(1, 1), cB + hstep + kstep, voffB);
        PG8_WAIT_V(6); PG8_BAR;
    } else {
        PG8_STAGE(PG8_SB(0, 0), cB, voffB); PG8_STAGE(PG8_SA(0, 0), cA, voffA); PG8_STAGE(PG8_SB(0, 1), cB + hstep, voffB); PG8_STAGE(PG8_SA(0, 1), cA + hstep, voffA);
        if (wr == 1) PG8_BAR;
        PG8_WAIT_V(4); PG8_BAR;
        PG8_STAGE(PG8_SB(1, 0), cB + kstep, voffB); PG8_STAGE(PG8_SA(1, 0), cA + kstep, voffA); PG8_STAGE(PG8_SB(1, 1), cB + hstep + kstep, voffB);
        PG8_WAIT_V(6); PG8_BAR;
    }
    for (;;) {
        const bool has_next = S.next(ui + 1, nxt);
        const char* nA = has_next ? (const char*)g.A + (size_t)nxt.pm * tstep : cA; const char* nB = has_next ? (const char*)g.Bt + (size_t)nxt.pn * tstep : cB;
        for (int t = 0; t < nt; t += 2) {
            const bool last = (t == nt - 2);
            const char* a1 = cA + (size_t)(t + 1) * kstep;
            const char* a2 = last ? nA : cA + (size_t)(t + 2) * kstep; const char* b2 = last ? nB : cB + (size_t)(t + 2) * kstep;
            const char* a3 = a2 + kstep; const char* b3 = b2 + kstep;
            if (last && has_next) S.a_ready(nxt);
            if constexpr (SP2) {
            PG8_LDB(B0, 0, 0); PG8_LDB(B1, 0, 1); PG8_SCHED; PG8_LDA(At, 0, 0); PG8_STAGE(PG8_SA(1, 1), a1 + hstep, voffA);
            PG8_WAIT_V(8); PG8_WAIT_L(0); PG8_BAR; PG8_MMA(0, 0, At, B0); PG8_MMA(0, 1, At, B1); PG8_BAR; PG8_SCHED;
            PG8_LDA(At, 0, 1); PG8_STAGE(PG8_SB(0, 0), b2, voffB); PG8_STAGE(PG8_SB(0, 1), b2 + hstep, voffB); PG8_STAGE(PG8_SA(0, 0), a2, voffA);
            PG8_WAIT_V(8); PG8_WAIT_L(0); PG8_BAR; PG8_MMA(1, 0, At, B0); PG8_MMA(1, 1, At, B1); PG8_BAR; PG8_SCHED;
            PG8_LDB(B0, 1, 0); PG8_LDB(B1, 1, 1); PG8_SCHED; PG8_LDA(At, 1, 0); PG8_STAGE(PG8_SA(0, 1), a2 + hstep, voffA);
            PG8_WAIT_V(8); PG8_WAIT_L(0); PG8_BAR; PG8_MMA(0, 0, At, B0); PG8_MMA(0, 1, At, B1); PG8_BAR; PG8_SCHED;
            PG8_LDA(At, 1, 1); PG8_STAGE(PG8_SB(1, 0), b3, voffB); PG8_STAGE(PG8_SB(1, 1), b3 + hstep, voffB); PG8_STAGE(PG8_SA(1, 0), a3, voffA);
            PG8_WAIT_V(8); PG8_WAIT_L(0); PG8_BAR; PG8_MMA(1, 0, At, B0); PG8_MMA(1, 1, At, B1); PG8_BAR; PG8_SCHED;
            } else {
            PG8_LDB(B0, 0, 0); PG8_SCHED; PG8_LDA(At, 0, 0); PG8_STAGE(PG8_SA(1, 1), a1 + hstep, voffA);
            PG8_WAIT_L(8); PG8_BAR; PG8_WAIT_L(0); PG8_MMA(0, 0, At, B0); PG8_BAR; PG8_SCHED;
            PG8_LDB(B1, 0, 1); PG8_STAGE(PG8_SB(0, 0), b2, voffB);
            PG8_BAR; PG8_WAIT_L(0); PG8_MMA(0, 1, At, B1); PG8_BAR;
            PG8_LDA(At, 0, 1); PG8_STAGE(PG8_SA(0, 0), a2, voffA);
            PG8_BAR; PG8_WAIT_L(0); PG8_MMA(1, 0, At, B0); PG8_BAR; PG8_SCHED;
            PG8_STAGE(PG8_SB(0, 1), b2 + hstep, voffB);
            PG8_WAIT_V(6); PG8_BAR; PG8_MMA(1, 1, At, B1); PG8_BAR;
            PG8_LDB(B0, 1, 0); PG8_SCHED; PG8_LDA(At, 1, 0); PG8_STAGE(PG8_SA(0, 1), a2 + hstep, voffA);
            PG8_WAIT_L(8); PG8_BAR; PG8_WAIT_L(0); PG8_MMA(0, 0, At, B0); PG8_BAR; PG8_SCHED;
            PG8_LDB(B1, 1, 1); PG8_STAGE(PG8_SB(1, 0), b3, voffB);
            PG8_BAR; PG8_WAIT_L(0); PG8_MMA(0, 1, At, B1); PG8_BAR;
            PG8_LDA(At, 1, 1); PG8_STAGE(PG8_SA(1, 0), a3, voffA);
            PG8_BAR; PG8_WAIT_L(0); PG8_MMA(1, 0, At, B0); PG8_BAR; PG8_SCHED;
            PG8_STAGE(PG8_SB(1, 1), b3 + hstep, voffB);
            PG8_WAIT_V(6); PG8_BAR; PG8_MMA(1, 1, At, B1); PG8_BAR;
            }
        }
        if constexpr (ALIGN_EPI) { if (wr == 0) PG8_BAR; }
        if constexpr (!Epi::AFTER_DRAIN) { E(acc, cur, wr, wc, fr, fq); S.done(cur); }
        if (!has_next) break;
#pragma unroll
        for (int a = 0; a < 2; ++a)
#pragma unroll
            for (int b = 0; b < 2; ++b)
#pragma unroll
                for (int m = 0; m < 4; ++m)
#pragma unroll
                    for (int n = 0; n < 2; ++n) acc[a][b][m][n] = (f32x4){0.f, 0.f, 0.f, 0.f};
        cur = nxt; cA = nA; cB = nB; ++ui;
        if constexpr (ALIGN_EPI) { if (wr == 1) PG8_BAR; }
    }
    PG8_WAIT_V(0);
    if constexpr (!ALIGN_EPI) { if (wr == 0) PG8_BAR; }
    PG8_BAR;
    if constexpr (Epi::AFTER_DRAIN) { E.fused(acc, cur, wr, wc, fr, fq, lds, wid, lane); S.done(cur); }
#undef PG8_SA
#undef PG8_SB
#undef PG8_STAGE
#undef PG8_LDA
#undef PG8_LDB
#undef PG8_MMA
#undef PG8_WAIT_V
#undef PG8_WAIT_L
#undef PG8_BAR
#undef PG8_SCHED
}
}

#define LAS __attribute__((address_space(3)))
using pg8::bf16_t; using pg8::bf16x8; using pg8::f32x4; using pg8::u32x4; using pg8::cvt_pk_bf16;
typedef float f32x16 __attribute__((ext_vector_type(16)));
typedef float f32x2v __attribute__((ext_vector_type(2)));
typedef unsigned u32x2 __attribute__((ext_vector_type(2)));
constexpr int NB = 16, SEQ = 2048, T = NB * SEQ, D = 1024, FF = 2816;
constexpr int CONVC = 512, TAPS = 31, SSMW = 512, NG = 32, NS = 64, NH = 8, HD = 128;
constexpr int NWAVES = 8, NTHREADS = 512;
constexpr int LDS_BYTES = 147456;
constexpr int LDS_RTAB_OFF = 131072;
constexpr size_t MiB = 1u << 20;
constexpr size_t WS_KMEAN = 0, WS_SST = 2 * MiB, WS_SS = 88 * MiB;
constexpr size_t WS_WUP = 8 * MiB, WS_WDN = 52 * MiB, WS_WIN = 74 * MiB, WS_WGLU = 77 * MiB, WS_WOUT = 78 * MiB, WS_WQK = 80 * MiB, WS_WV = 84 * MiB, WS_WO = 86 * MiB;
constexpr size_t WUP_STRIDE = 11 * MiB, WDN_STRIDE = (size_t)D * FF * 2;
constexpr size_t WS_H = 104 * MiB, WS_BIG = 168 * MiB;
constexpr size_t WS_U = WS_BIG, WS_VC = WS_BIG, WS_US = WS_BIG + 32 * MiB, WS_YB = WS_BIG + 96 * MiB, WS_CAT = WS_BIG + 128 * MiB;
constexpr size_t WS_QK = WS_BIG, WS_VT = WS_BIG + 128 * MiB, WS_OA = WS_BIG + 192 * MiB, WS_END = WS_BIG + 256 * MiB;
constexpr float C2 = 0.08838834764831845f * 1.4426950408889634f;
constexpr float LOG2E = 1.4426950408889634f;

__device__ __forceinline__ float bf_lo(unsigned w) { return __builtin_bit_cast(float, w << 16); }
__device__ __forceinline__ float bf_hi(unsigned w) { return __builtin_bit_cast(float, w & 0xffff0000u); }
__device__ __forceinline__ float fast_sigmoid(float x) { return __builtin_amdgcn_rcpf(1.f + __builtin_amdgcn_exp2f(-x * LOG2E)); }
__device__ __forceinline__ float fast_silu(float x) { return x * fast_sigmoid(x); }
__device__ __forceinline__ float gelu_tanh(float x) { const float z = 0.7978845608028654f * (x + 0.044715f * x * x * x); const float e = __builtin_amdgcn_exp2f(2.f * LOG2E * z); return 0.5f * x * (2.f - 2.f * __builtin_amdgcn_rcpf(1.f + e)); }
__device__ __forceinline__ float rs_of(float ss) { return 1.0f / sqrtf(ss * (1.f / 1024.f) + 1e-6f); }
constexpr int SSN = 16 * T;
__device__ __forceinline__ float row_scale(const float* SSP, int row, int fq) {
    const float* p = SSP + (size_t)(4 * fq) * T + row; float t = (p[0] + p[T]) + (p[2 * T] + p[3 * T]);
    t += __shfl_xor(t, 16); t += __shfl_xor(t, 32); return rs_of(t);
}
__device__ __forceinline__ float wave_sum(float v) {
#pragma unroll
    for (int o = 1; o < 64; o <<= 1) v += __shfl_xor(v, o);
    return v;
}

typedef float f32x2c __attribute__((ext_vector_type(2))); typedef __bf16 bf16x2c __attribute__((ext_vector_type(2)));
__device__ __forceinline__ unsigned cvt_pk2(float lo, float hi) { f32x2c v = {lo, hi}; bf16x2c q = __builtin_convertvector(v, bf16x2c); return __builtin_bit_cast(unsigned, q); }
struct RTab { const LAS float* tab; int p0, p1, p2, p3;
    __device__ __forceinline__ const LAS float* of(int p) const { return tab + (p == p0 ? 0 : (p == p1 ? 1 : (p == p2 ? 2 : 3))) * 256; } };
struct EpiSwiglu {
    static constexpr bool PERM = true, AFTER_DRAIN = false; bf16_t* O; RTab rt_;
    __device__ __forceinline__ void operator()(const f32x4 (&acc)[2][2][4][2], const pg8::Unit& u, int wr, int wc, int fr, int fq) const {
        const int row0 = u.pm * 256 + wr * 64 + fr, col0 = u.pn * 128 + wc * 32 + 8 * fq;
        const LAS float* rt = rt_.of(u.pm) + wr * 64 + fr;
#pragma unroll
        for (int ai = 0; ai < 2; ++ai)
#pragma unroll
            for (int m = 0; m < 4; ++m) { bf16_t* rowp = O + (size_t)(row0 + ai * 128 + m * 16) * FF + col0; const float r = rt[ai * 128 + m * 16];
                const float rl = -r * LOG2E, r2 = r * r; unsigned w[4];
#pragma unroll
                for (int n = 0; n < 2; ++n)
#pragma unroll
                    for (int h = 0; h < 2; ++h) { const f32x2v g = {acc[ai][0][m][n][2 * h], acc[ai][0][m][n][2 * h + 1]}, uu = {acc[ai][1][m][n][2 * h], acc[ai][1][m][n][2 * h + 1]};
                        const f32x2v t = g * rl; f32x2v d = {__builtin_amdgcn_exp2f(t.x), __builtin_amdgcn_exp2f(t.y)}; d = d + 1.0f;
                        const f32x2v q = {__builtin_amdgcn_rcpf(d.x), __builtin_amdgcn_rcpf(d.y)}; const f32x2v o = ((g * uu) * r2) * q;
                        w[2 * n + h] = cvt_pk2(o.x, o.y); }
                u32x4 wv; wv.x = w[0]; wv.y = w[1]; wv.z = w[2]; wv.w = w[3];
                *(u32x4*)rowp = wv; }
    }
};
struct EpiResid {
    static constexpr bool PERM = true, AFTER_DRAIN = false; bf16_t* XB; float s; float* SSo;
    __device__ __forceinline__ void operator()(const f32x4 (&acc)[2][2][4][2], const pg8::Unit& u, int wr, int wc, int fr, int fq) const {
        const int row0 = u.pm * 256 + wr * 64 + fr, col0 = u.pn * 256 + wc * 32 + 8 * fq;
        u32x4 xin[2][4][2];
#pragma unroll
        for (int ai = 0; ai < 2; ++ai)
#pragma unroll
            for (int m = 0; m < 4; ++m)
#pragma unroll
                for (int bj = 0; bj < 2; ++bj) xin[ai][m][bj] = *(const u32x4*)(XB + (size_t)(row0 + ai * 128 + m * 16) * D + col0 + bj * 128);
#pragma unroll
        for (int ai = 0; ai < 2; ++ai)
#pragma unroll
            for (int m = 0; m < 4; ++m) { const size_t ro = (size_t)(row0 + ai * 128 + m * 16) * D + col0; float sq = 0.f;
#pragma unroll
                for (int bj = 0; bj < 2; ++bj) { const u32x4 xb = xin[ai][m][bj];
                    const f32x4 x0 = (f32x4){bf_lo(xb.x), bf_hi(xb.x), bf_lo(xb.y), bf_hi(xb.y)} + acc[ai][bj][m][0] * s, x1 = (f32x4){bf_lo(xb.z), bf_hi(xb.z), bf_lo(xb.w), bf_hi(xb.w)} + acc[ai][bj][m][1] * s;
                    sq += (x0[0] * x0[0] + x0[1] * x0[1]) + (x0[2] * x0[2] + x0[3] * x0[3]) + (x1[0] * x1[0] + x1[1] * x1[1]) + (x1[2] * x1[2] + x1[3] * x1[3]);
                    u32x4 w; w.x = cvt_pk_bf16(x0[0], x0[1]); w.y = cvt_pk_bf16(x0[2], x0[3]); w.z = cvt_pk_bf16(x1[0], x1[1]); w.w = cvt_pk_bf16(x1[2], x1[3]);
                    *(u32x4*)(XB + ro + bj * 128) = w; }
                sq += __shfl_xor(sq, 16); sq += __shfl_xor(sq, 32);
                if (fq == 0) SSo[(size_t)(u.pn * 4 + wc) * T + row0 + ai * 128 + m * 16] = sq; }
    }
};
struct EpiWin {
    static constexpr bool PERM = true, AFTER_DRAIN = false; bf16_t* VC; bf16_t* US; RTab rt_;
    __device__ __forceinline__ void operator()(const f32x4 (&acc)[2][2][4][2], const pg8::Unit& u, int wr, int wc, int fr, int fq) const {
        const int row0 = u.pm * 256 + wr * 64 + fr; const LAS float* rt = rt_.of(u.pm) + wr * 64 + fr;
        if (u.pn < 4) { const int col0 = u.pn * 128 + wc * 32 + 8 * fq;
#pragma unroll
            for (int ai = 0; ai < 2; ++ai)
#pragma unroll
                for (int m = 0; m < 4; ++m) { bf16_t* rowp = VC + (size_t)(row0 + ai * 128 + m * 16) * CONVC + col0; const float r = rt[ai * 128 + m * 16];
                    const f32x4 a0 = acc[ai][0][m][0] * r, a1 = acc[ai][0][m][1] * r, g0 = acc[ai][1][m][0] * r, g1 = acc[ai][1][m][1] * r;
                    u32x4 w; w.x = cvt_pk_bf16(a0[0] * fast_sigmoid(g0[0]), a0[1] * fast_sigmoid(g0[1])); w.y = cvt_pk_bf16(a0[2] * fast_sigmoid(g0[2]), a0[3] * fast_sigmoid(g0[3]));
                    w.z = cvt_pk_bf16(a1[0] * fast_sigmoid(g1[0]), a1[1] * fast_sigmoid(g1[1])); w.w = cvt_pk_bf16(a1[2] * fast_sigmoid(g1[2]), a1[3] * fast_sigmoid(g1[3]));
                    *(u32x4*)rowp = w; }
        } else { const int col0 = (u.pn - 4) * 256 + wc * 32 + 8 * fq;
#pragma unroll
            for (int ai = 0; ai < 2; ++ai)
#pragma unroll
                for (int m = 0; m < 4; ++m) { bf16_t* rowp = US + (size_t)(row0 + ai * 128 + m * 16) * SSMW + col0; const float r = rt[ai * 128 + m * 16];
#pragma unroll
                    for (int bj = 0; bj < 2; ++bj) { const f32x4 v0 = acc[ai][bj][m][0] * r, v1 = acc[ai][bj][m][1] * r;
                        u32x4 w; w.x = cvt_pk_bf16(v0[0], v0[1]); w.y = cvt_pk_bf16(v0[2], v0[3]); w.z = cvt_pk_bf16(v1[0], v1[1]); w.w = cvt_pk_bf16(v1[2], v1[3]);
                        *(u32x4*)(rowp + bj * 128) = w; } }
        }
    }
};
struct EpiBf {
    static constexpr bool PERM = true, AFTER_DRAIN = false; bf16_t* O; int ldc; int nscaled; float sc; RTab rt_; float* KMs;
    __device__ __forceinline__ void operator()(const f32x4 (&acc)[2][2][4][2], const pg8::Unit& u, int wr, int wc, int fr, int fq) const {
        const int row0 = u.pm * 256 + wr * 64 + fr, col0 = u.pn * 256 + wc * 32 + 8 * fq; const float s = (u.pn < nscaled) ? sc : 1.f; const LAS float* rt = rt_.of(u.pm) + wr * 64 + fr;
        f32x4 cs[2][2];
#pragma unroll
        for (int bj = 0; bj < 2; ++bj)
#pragma unroll
            for (int n = 0; n < 2; ++n) cs[bj][n] = (f32x4){0.f, 0.f, 0.f, 0.f};
#pragma unroll
        for (int ai = 0; ai < 2; ++ai)
#pragma unroll
            for (int m = 0; m < 4; ++m) { bf16_t* rowp = O + (size_t)(row0 + ai * 128 + m * 16) * ldc + col0; const float r = s * rt[ai * 128 + m * 16];
#pragma unroll
                for (int bj = 0; bj < 2; ++bj) { const f32x4 v0 = acc[ai][bj][m][0] * r, v1 = acc[ai][bj][m][1] * r; cs[bj][0] += v0; cs[bj][1] += v1;
                    u32x4 w; w.x = cvt_pk_bf16(v0[0], v0[1]); w.y = cvt_pk_bf16(v0[2], v0[3]); w.z = cvt_pk_bf16(v1[0], v1[1]); w.w = cvt_pk_bf16(v1[2], v1[3]);
                    *(u32x4*)(rowp + bj * 128) = w; } }
        if (KMs && u.pn >= 4) {
#pragma unroll
            for (int bj = 0; bj < 2; ++bj)
#pragma unroll
                for (int n = 0; n < 2; ++n)
#pragma unroll
                    for (int e = 0; e < 4; ++e) { float t = cs[bj][n][e]; t += __shfl_xor(t, 1); t += __shfl_xor(t, 2); t += __shfl_xor(t, 4); t += __shfl_xor(t, 8);
                        if (fr == 0) { const int c = col0 + bj * 128 + 4 * n + e - 1024; unsafeAtomicAdd(KMs + ((size_t)((u.pm >> 3) * NH + (c >> 7)) * 8 + (u.pm & 7)) * HD + (c & 127), t); } }
        }
    }
};
struct EpiVT {
    static constexpr bool PERM = true, AFTER_DRAIN = false; bf16_t* O; RTab rt_;
    __device__ __forceinline__ void operator()(const f32x4 (&acc)[2][2][4][2], const pg8::Unit& u, int wr, int wc, int fr, int fq) const {
        const int row0 = u.pm * 256 + wr * 64 + fr, col0 = u.pn * 256 + wc * 32 + 8 * fq;
        f32x4 rv[2][2]; const LAS float* rt = rt_.of(u.pn) + wc * 32 + 8 * fq;
#pragma unroll
        for (int bj = 0; bj < 2; ++bj)
#pragma unroll
            for (int n = 0; n < 2; ++n) rv[bj][n] = *(const LAS f32x4*)(rt + bj * 128 + 4 * n);
#pragma unroll
        for (int ai = 0; ai < 2; ++ai)
#pragma unroll
            for (int m = 0; m < 4; ++m) { const int dg = row0 + ai * 128 + m * 16, hh = dg >> 7, d = dg & 127;
#pragma unroll
                for (int bj = 0; bj < 2; ++bj) { const int tok = col0 + bj * 128, bb = tok >> 11, tl = tok & 2047;
                    const f32x4 v0 = acc[ai][bj][m][0] * rv[bj][0], v1 = acc[ai][bj][m][1] * rv[bj][1];
                    u32x4 w; w.x = cvt_pk_bf16(v0[0], v0[1]); w.y = cvt_pk_bf16(v0[2], v0[3]); w.z = cvt_pk_bf16(v1[0], v1[1]); w.w = cvt_pk_bf16(v1[2], v1[3]);
                    *(u32x4*)(O + ((((size_t)(bb * 8 + hh) * 32 + (tl >> 6)) * 128 + d) * 64 + (tl & 63))) = w; } }
    }
};
struct EpiGlu {
    static constexpr bool PERM = true, AFTER_DRAIN = false; const bf16_t* YB; const float* bias; bf16_t* CAT;
    __device__ __forceinline__ void operator()(const f32x4 (&acc)[2][2][4][2], const pg8::Unit& u, int wr, int wc, int fr, int fq) const {
        const int row0 = u.pm * 256 + wr * 64 + fr, col0 = u.pn * 256 + wc * 32 + 8 * fq;
#pragma unroll
        for (int bj = 0; bj < 2; ++bj) { const int c = col0 + bj * 128; const f32x4 b0 = *(const f32x4*)(bias + c), b1 = *(const f32x4*)(bias + c + 4);
#pragma unroll
            for (int ai = 0; ai < 2; ++ai)
#pragma unroll
                for (int m = 0; m < 4; ++m) { const size_t r = (size_t)(row0 + ai * 128 + m * 16);
                    const u32x4 y = *(const u32x4*)(YB + r * SSMW + c); const f32x4 v0 = acc[ai][bj][m][0] + b0, v1 = acc[ai][bj][m][1] + b1;
                    u32x4 w; w.x = cvt_pk_bf16(bf_lo(y.x) * fast_sigmoid(v0[0]), bf_hi(y.x) * fast_sigmoid(v0[1])); w.y = cvt_pk_bf16(bf_lo(y.y) * fast_sigmoid(v0[2]), bf_hi(y.y) * fast_sigmoid(v0[3]));
                    w.z = cvt_pk_bf16(bf_lo(y.z) * fast_sigmoid(v1[0]), bf_hi(y.z) * fast_sigmoid(v1[1])); w.w = cvt_pk_bf16(bf_lo(y.w) * fast_sigmoid(v1[2]), bf_hi(y.w) * fast_sigmoid(v1[3]));
                    *(u32x4*)(CAT + r * D + 512 + c) = w; } }
    }
};

struct TrDesc { const float* W; const float* gain; bf16_t* WT; int ldw, K, drow0, k0, n0; };
__device__ __forceinline__ TrDesc tr_desc(const float* W, int ldw, int K, bf16_t* WT, int nblk, int mode, int arg, const float* gain, int item) {
    TrDesc d; const int kb = item / nblk, nb = item % nblk; d.k0 = 64 * kb; d.n0 = 32 * nb; d.W = W; d.gain = gain; d.WT = WT; d.ldw = ldw; d.K = K;
    d.drow0 = mode == 0 ? arg + d.n0 : (d.n0 >> 7) * 256 + arg * 128 + (d.n0 & 127); return d;
}
__device__ __forceinline__ void tr_load(const TrDesc& d, float (&v)[32], int lane) {
#pragma unroll
    for (int i = 0; i < 32; ++i) { const int kk = 2 * i + (lane >> 5); v[i] = d.W[(size_t)(d.k0 + kk) * d.ldw + d.n0 + (lane & 31)]; }
}
__device__ __forceinline__ void tr_store(const TrDesc& d, float (&v)[32], LAS float* scr, int lane) {
    if (d.gain) {
#pragma unroll
        for (int i = 0; i < 32; ++i) v[i] *= d.gain[d.k0 + 2 * i + (lane >> 5)]; }
#pragma unroll
    for (int i = 0; i < 32; ++i) { const int kk = 2 * i + (lane >> 5); scr[kk * 33 + (lane & 31)] = v[i]; }
    asm volatile("s_waitcnt lgkmcnt(0)" ::: "memory");
    const int c = lane & 7;
#pragma unroll
    for (int j = 0; j < 4; ++j) { const int n = (lane >> 3) + 8 * j; const LAS float* s = scr + (8 * c) * 33 + n;
        u32x4 o; o.x = cvt_pk_bf16(s[0 * 33], s[1 * 33]); o.y = cvt_pk_bf16(s[2 * 33], s[3 * 33]); o.z = cvt_pk_bf16(s[4 * 33], s[5 * 33]); o.w = cvt_pk_bf16(s[6 * 33], s[7 * 33]);
        *(u32x4*)(d.WT + (size_t)(d.drow0 + n) * d.K + d.k0 + 8 * c) = o; }
    asm volatile("s_waitcnt lgkmcnt(0)" ::: "memory");
}

__device__ __forceinline__ void xb_rows(const float* X, bf16_t* XB, float* SS0, int gw, int NGW, int lane) {
    for (int m0 = 4 * gw; m0 < T; m0 += 4 * NGW) { f32x4 v[4][4];
#pragma unroll
        for (int q = 0; q < 4; ++q)
#pragma unroll
            for (int j = 0; j < 4; ++j) v[q][j] = ((const f32x4*)(X + (size_t)(m0 + q) * D) + lane)[64 * j];
#pragma unroll
        for (int q = 0; q < 4; ++q) { float s = 0.f;
#pragma unroll
            for (int j = 0; j < 4; ++j) s += (v[q][j].x * v[q][j].x + v[q][j].y * v[q][j].y) + (v[q][j].z * v[q][j].z + v[q][j].w * v[q][j].w);
            s = wave_sum(s); if (lane < 16) SS0[(size_t)lane * T + m0 + q] = (lane == 0) ? s : 0.f;
            u32x2* o = (u32x2*)(XB + (size_t)(m0 + q) * D) + lane;
#pragma unroll
            for (int j = 0; j < 4; ++j) { u32x2 w; w.x = cvt_pk_bf16(v[q][j].x, v[q][j].y); w.y = cvt_pk_bf16(v[q][j].z, v[q][j].w); o[64 * j] = w; } } }
}
__device__ __forceinline__ void final_rows(const bf16_t* XB, float* out, const float* g, const float* SS, int gw, int NGW, int lane) {
    f32x4 gv[4];
#pragma unroll
    for (int j = 0; j < 4; ++j) gv[j] = ((const f32x4*)g)[lane + 64 * j];
    for (int m0 = 4 * gw; m0 < T; m0 += 4 * NGW) {
        u32x2 w[4][4]; float tp[4];
#pragma unroll
        for (int q = 0; q < 4; ++q) { const u32x2* xr = (const u32x2*)(XB + (size_t)(m0 + q) * D) + lane;
#pragma unroll
            for (int j = 0; j < 4; ++j) w[q][j] = xr[64 * j];
            tp[q] = (lane < 16) ? SS[(size_t)lane * T + m0 + q] : 0.f; }
#pragma unroll
        for (int q = 0; q < 4; ++q) { float t = tp[q]; t += __shfl_xor(t, 1); t += __shfl_xor(t, 2); t += __shfl_xor(t, 4); t += __shfl_xor(t, 8); const float r = rs_of(__shfl(t, 0));
            f32x4* o = (f32x4*)(out + (size_t)(m0 + q) * D) + lane;
#pragma unroll
            for (int j = 0; j < 4; ++j) o[64 * j] = (f32x4){bf_lo(w[q][j].x), bf_hi(w[q][j].x), bf_lo(w[q][j].y), bf_hi(w[q][j].y)} * r * gv[j]; } }
}

__device__ __forceinline__ void conv_phase(LAS unsigned char* lds, const bf16_t* VC, const float* cw, const float* cb, const float* lng, const float* lnb, bf16_t* CAT, int tid, int lane, int wave) {
    const int cp = tid & 255, th = tid >> 8;
    f32x2v wk[TAPS];
#pragma unroll
    for (int k = 0; k < TAPS; ++k) wk[k] = *(const f32x2v*)(cw + k * CONVC + 2 * cp);
    const f32x2v bias = *(const f32x2v*)(cb + 2 * cp);
    LAS float* ybuf = (LAS float*)lds;
    unsigned vn[38];
#define CONV_LOAD(dst, it_) do { const int t0_ = (it_) * 16 + th * 8, tb_ = t0_ & (SEQ - 1); \
        _Pragma("unroll") for (int r = 0; r < 38; ++r) { const int pos = tb_ - 30 + r; dst[r] = *(const unsigned*)(VC + (size_t)(t0_ - tb_ + (pos < 0 ? 0 : pos)) * CONVC + 2 * cp); } } while (0)
    const int G_ = (int)gridDim.x, vcu = (G_ % 8 == 0) ? (int)(blockIdx.x % 8) * (G_ / 8) + (int)(blockIdx.x / 8) : (int)blockIdx.x;
    if (vcu < T / 16) CONV_LOAD(vn, vcu);
    for (int it = vcu; it < T / 16; it += gridDim.x) {
        const int t0 = it * 16 + th * 8, tb = t0 & (SEQ - 1);
        f32x2v av[8];
#pragma unroll
        for (int t = 0; t < 8; ++t) av[t] = bias;
        unsigned vv[38];
#pragma unroll
        for (int r = 0; r < 38; ++r) vv[r] = vn[r];
        if (it + (int)gridDim.x < T / 16) CONV_LOAD(vn, it + (int)gridDim.x);
#pragma unroll
        for (int r = 0; r < 38; ++r) {
            const unsigned v = (tb - 30 + r >= 0) ? vv[r] : 0u;
            const f32x2v vf = {bf_lo(v), bf_hi(v)};
#pragma unroll
            for (int t = 0; t < 8; ++t) { const int k = r - t; if (k >= 0 && k < TAPS) av[t] = __builtin_elementwise_fma(wk[k], vf, av[t]); }
        }
#pragma unroll
        for (int t = 0; t < 8; ++t) *(LAS f32x2v*)(ybuf + (th * 8 + t) * CONVC + 2 * cp) = av[t];
        __syncthreads();
        {   f32x4 y0[2], y1[2]; float sm[2], sq[2];
#pragma unroll
            for (int q = 0; q < 2; ++q) { const LAS float* yr = ybuf + (wave * 2 + q) * CONVC + lane * 8; y0[q] = *(const LAS f32x4*)yr; y1[q] = *(const LAS f32x4*)(yr + 4);
                sm[q] = (y0[q].x + y0[q].y) + (y0[q].z + y0[q].w) + (y1[q].x + y1[q].y) + (y1[q].z + y1[q].w);
                sq[q] = (y0[q].x * y0[q].x + y0[q].y * y0[q].y) + (y0[q].z * y0[q].z + y0[q].w * y0[q].w) + (y1[q].x * y1[q].x + y1[q].y * y1[q].y) + (y1[q].z * y1[q].z + y1[q].w * y1[q].w); }
#pragma unroll
            for (int o = 1; o < 64; o <<= 1) { const float a0 = __shfl_xor(sm[0], o), a1 = __shfl_xor(sq[0], o), a2 = __shfl_xor(sm[1], o), a3 = __shfl_xor(sq[1], o); sm[0] += a0; sq[0] += a1; sm[1] += a2; sq[1] += a3; }
            const f32x4 g0 = *(const f32x4*)(lng + lane * 8), g1 = *(const f32x4*)(lng + lane * 8 + 4), b0 = *(const f32x4*)(lnb + lane * 8), b1 = *(const f32x4*)(lnb + lane * 8 + 4);
#pragma unroll
            for (int q = 0; q < 2; ++q) { const float mu = sm[q] * (1.f / CONVC); const float var = fmaxf(sq[q] * (1.f / CONVC) - mu * mu, 0.f);
                const float rs = 1.0f / sqrtf(var + 1e-5f);
                const f32x4 z0 = (y0[q] - mu) * rs * g0 + b0, z1 = (y1[q] - mu) * rs * g1 + b1;
                u32x4 w; w.x = cvt_pk_bf16(fast_silu(z0.x), fast_silu(z0.y)); w.y = cvt_pk_bf16(fast_silu(z0.z), fast_silu(z0.w)); w.z = cvt_pk_bf16(fast_silu(z1.x), fast_silu(z1.y)); w.w = cvt_pk_bf16(fast_silu(z1.z), fast_silu(z1.w));
                *(u32x4*)(CAT + (size_t)(it * 16 + wave * 2 + q) * D + lane * 8) = w; } }
        __syncthreads();
    }
}

constexpr size_t WS_ABAR = 1 * MiB, WS_BBH = 1 * MiB + 65536, WS_BBL = 1 * MiB + 262144;
constexpr size_t WS_CMH = 1 * MiB + 393216, WS_CML = 1 * MiB + 589824;
constexpr int TSTR = 132;
__device__ __forceinline__ void ssm_tables(int idx, const float* a_re, const float* a_im, const float* b_re, const float* b_im, const float* log_dt, float* ABAR, bf16_t* BBH, bf16_t* BBL) {
    const int g = idx >> 6, p = idx & 63;
    const float dt = expf(log_dt[g]), are = a_re[idx], aim = a_im[idx];
    const float mag = expf(dt * are), ang = dt * aim, ar = mag * cosf(ang), ai = mag * sinf(ang);
    ABAR[2 * idx] = ar; ABAR[2 * idx + 1] = ai;
    const float den = are * are + aim * aim, nr = ar - 1.f, ni = ai;
    const float qr = (nr * are + ni * aim) / den, qi = (ni * are - nr * aim) / den;
    const float* pbr = b_re + (size_t)idx * 16; const float* pbi = b_im + (size_t)idx * 16;
#pragma unroll
    for (int h8 = 0; h8 < 2; ++h8) { float vr[8], vi[8];
#pragma unroll
        for (int e = 0; e < 8; ++e) { const float r = pbr[8 * h8 + e], i = pbi[8 * h8 + e]; vr[e] = qr * r - qi * i; vi[e] = qr * i + qi * r; }
        u32x4 hr, lr, hi, li;
#pragma unroll
        for (int e = 0; e < 4; ++e) { const unsigned a = cvt_pk_bf16(vr[2 * e], vr[2 * e + 1]); hr[e] = a; lr[e] = cvt_pk_bf16(vr[2 * e] - bf_lo(a), vr[2 * e + 1] - bf_hi(a));
            const unsigned c = cvt_pk_bf16(vi[2 * e], vi[2 * e + 1]); hi[e] = c; li[e] = cvt_pk_bf16(vi[2 * e] - bf_lo(c), vi[2 * e + 1] - bf_hi(c)); }
        *(u32x4*)(BBH + ((size_t)(g * 128 + p) * 16 + 8 * h8)) = hr; *(u32x4*)(BBL + ((size_t)(g * 128 + p) * 16 + 8 * h8)) = lr;
        *(u32x4*)(BBH + ((size_t)(g * 128 + 64 + p) * 16 + 8 * h8)) = hi; *(u32x4*)(BBL + ((size_t)(g * 128 + 64 + p) * 16 + 8 * h8)) = li; }
}
__device__ __forceinline__ void ssm_ctable(int idx, const float* c_re, const float* c_im, bf16_t* CMH, bf16_t* CML) {
    const int gh = idx >> 4, c8 = idx & 15; const float* src = (c8 < 8 ? c_re : c_im) + (size_t)gh * NS + (c8 & 7) * 8; const float sg = c8 < 8 ? 1.f : -1.f;
    const f32x4 a = *(const f32x4*)src * sg, b = *(const f32x4*)(src + 4) * sg;
    u32x4 h, l;
    h.x = cvt_pk_bf16(a[0], a[1]); h.y = cvt_pk_bf16(a[2], a[3]); h.z = cvt_pk_bf16(b[0], b[1]); h.w = cvt_pk_bf16(b[2], b[3]);
    l.x = cvt_pk_bf16(a[0] - bf_lo(h.x), a[1] - bf_hi(h.x)); l.y = cvt_pk_bf16(a[2] - bf_lo(h.y), a[3] - bf_hi(h.y)); l.z = cvt_pk_bf16(b[0] - bf_lo(h.z), b[1] - bf_hi(h.z)); l.w = cvt_pk_bf16(b[2] - bf_lo(h.w), b[3] - bf_hi(h.w));
    *(u32x4*)(CMH + (size_t)gh * 128 + c8 * 8) = h; *(u32x4*)(CML + (size_t)gh * 128 + c8 * 8) = l;
}
struct SsmOps { bf16x8 bh[8]; float ar, ai; };
__device__ __forceinline__ void ssm_ops_load(SsmOps& S, const float* ABAR, const bf16_t* BBH, const bf16_t* BBL, int g, int lane) {
    const int fr = lane & 15, fq = lane >> 4; const bf16x8 z = {0, 0, 0, 0, 0, 0, 0, 0};
#pragma unroll
    for (int nb = 0; nb < 8; ++nb) { const size_t o = (size_t)(g * 128 + 16 * nb + fr) * 16 + (fq & 1) * 8;
        const bf16x8 h = *(const bf16x8*)(BBH + o); S.bh[nb] = fq < 2 ? h : z; }
    S.ar = ABAR[2 * (g * 64 + lane)]; S.ai = ABAR[2 * (g * 64 + lane) + 1];
}
__device__ __forceinline__ void ssm_u_load(bf16x8& uh, const bf16_t* US, int tok, int g, int lane) {
    uh = *(const bf16x8*)(US + (size_t)(tok + (lane & 15)) * SSMW + g * 16 + ((lane >> 4) & 1) * 8);
}
__device__ __forceinline__ void ssm_bu_tile(const SsmOps& S, bf16x8 uh, LAS float* tile, int lane) {
    const int fr = lane & 15, fq = lane >> 4;
    if (fq >= 2) uh = (bf16x8){0, 0, 0, 0, 0, 0, 0, 0};
#pragma unroll
    for (int nb = 0; nb < 8; ++nb) { f32x4 acc = {0.f, 0.f, 0.f, 0.f};
        acc = __builtin_amdgcn_mfma_f32_16x16x32_bf16(S.bh[nb], uh, acc, 0, 0, 0);
        *(LAS f32x4*)(tile + fr * TSTR + 16 * nb + 4 * fq) = acc; }
    asm volatile("s_waitcnt lgkmcnt(0)" ::: "memory");
}
__device__ __forceinline__ void ssm_pass1(LAS unsigned char* lds, const bf16_t* US, float* SST, const float* ABAR, const bf16_t* BBH, const bf16_t* BBL, int gw, int NGW, int lane, int wave) {
    LAS float* tile = (LAS float*)(lds + 32768 + wave * (16 * TSTR * 4));
    for (int idx = gw; idx < NB * NG * 7; idx += NGW) {
        const int c = idx % 7, bg = idx / 7, b = bg >> 5, g = bg & 31;
        SsmOps S; ssm_ops_load(S, ABAR, BBH, BBL, g, lane);
        float xr = 0.f, xi = 0.f; const int tokc = b * SEQ + c * 256;
        bf16x8 uh; ssm_u_load(uh, US, tokc, g, lane);
        for (int grp = 0; grp < 16; ++grp) {
            ssm_bu_tile(S, uh, tile, lane);
            if (grp < 15) ssm_u_load(uh, US, tokc + (grp + 1) * 16, g, lane);
            float br[16], bi[16];
#pragma unroll
            for (int t = 0; t < 16; ++t) { br[t] = tile[t * TSTR + lane]; bi[t] = tile[t * TSTR + 64 + lane]; }
            asm volatile("s_waitcnt lgkmcnt(0)" ::: "memory");
#pragma unroll
            for (int t = 0; t < 16; ++t) { const float nr = S.ar * xr - S.ai * xi + br[t], ni = S.ar * xi + S.ai * xr + bi[t]; xr = nr; xi = ni; }
        }
        float* so = SST + ((size_t)bg * 8 + c) * 128; so[lane] = xr; so[64 + lane] = xi;
    }
}
__device__ __forceinline__ void ssm_pass2(LAS unsigned char* lds, const bf16_t* US, const float* SST, bf16_t* YB, const float* ABAR, const bf16_t* BBH, const bf16_t* BBL, const bf16_t* CMH, const bf16_t* CML, const float* dco, int gw, int NGW, int lane, int wave) {
    LAS float* tile = (LAS float*)(lds + wave * (16 * TSTR * 4));
    const int fr = lane & 15, fq = lane >> 4;
    for (int idx = gw; idx < NB * NG * 8; idx += NGW) {
        const int c = idx & 7, bg = idx >> 3, b = bg >> 5, g = bg & 31;
        SsmOps S; ssm_ops_load(S, ABAR, BBH, BBL, g, lane);
        bf16x8 ch[4];
#pragma unroll
        for (int ks = 0; ks < 4; ++ks) { const size_t o = (size_t)(g * 16 + fr) * 128 + ks * 32 + fq * 8; ch[ks] = *(const bf16x8*)(CMH + o); }
        const float dh = dco[g * 16 + fr];
        float pr = S.ar, pi = S.ai;
#pragma unroll
        for (int s = 0; s < 8; ++s) { const float nr = pr * pr - pi * pi, ni = 2.f * pr * pi; pr = nr; pi = ni; }
        float xr = 0.f, xi = 0.f;
        { float sr[7], sm[7];
#pragma unroll
          for (int cc = 0; cc < 7; ++cc) { const float* si = SST + ((size_t)bg * 8 + (cc < c ? cc : 0)) * 128; sr[cc] = si[lane]; sm[cc] = si[64 + lane]; }
#pragma unroll
          for (int cc = 0; cc < 7; ++cc) if (cc < c) { const float nr = pr * xr - pi * xi + sr[cc], ni = pr * xi + pi * xr + sm[cc]; xr = nr; xi = ni; } }
        const int tokc = b * SEQ + c * 256;
        bf16x8 uh; ssm_u_load(uh, US, tokc, g, lane);
        for (int grp = 0; grp < 16; ++grp) { const int tok = tokc + grp * 16;
            ssm_bu_tile(S, uh, tile, lane);
            if (grp < 15) ssm_u_load(uh, US, tok + 16, g, lane);
            float ud[4];
#pragma unroll
            for (int i = 0; i < 4; ++i) ud[i] = bf_lo((unsigned)US[(size_t)(tok + 4 * fq + i) * SSMW + g * 16 + fr]);
            float br[16], bi[16];
#pragma unroll
            for (int t = 0; t < 16; ++t) { br[t] = tile[t * TSTR + lane]; bi[t] = tile[t * TSTR + 64 + lane]; }
            asm volatile("s_waitcnt lgkmcnt(0)" ::: "memory");
#pragma unroll
            for (int t = 0; t < 16; ++t) { const float nr = S.ar * xr - S.ai * xi + br[t], ni = S.ar * xi + S.ai * xr + bi[t]; xr = nr; xi = ni; br[t] = xr; bi[t] = xi; }
#pragma unroll
            for (int t = 0; t < 16; ++t) { tile[t * TSTR + lane] = br[t]; tile[t * TSTR + 64 + lane] = bi[t]; }
            asm volatile("s_waitcnt lgkmcnt(0)" ::: "memory");
            f32x4 acc = {0.f, 0.f, 0.f, 0.f}, acc2 = {0.f, 0.f, 0.f, 0.f};
            f32x4 xa[4][2];
#pragma unroll
            for (int ks = 0; ks < 4; ++ks) { xa[ks][0] = *(const LAS f32x4*)(tile + fr * TSTR + ks * 32 + fq * 8); xa[ks][1] = *(const LAS f32x4*)(tile + fr * TSTR + ks * 32 + fq * 8 + 4); }
#pragma unroll
            for (int ks = 0; ks < 4; ++ks) { const f32x4 x0 = xa[ks][0], x1 = xa[ks][1]; u32x4 h;
                h.x = cvt_pk_bf16(x0[0], x0[1]); h.y = cvt_pk_bf16(x0[2], x0[3]); h.z = cvt_pk_bf16(x1[0], x1[1]); h.w = cvt_pk_bf16(x1[2], x1[3]);
                const bf16x8 xh = __builtin_bit_cast(bf16x8, h);
                if (ks & 1) acc2 = __builtin_amdgcn_mfma_f32_16x16x32_bf16(xh, ch[ks], acc2, 0, 0, 0); else acc = __builtin_amdgcn_mfma_f32_16x16x32_bf16(xh, ch[ks], acc, 0, 0, 0); }
            acc = acc + acc2;
#pragma unroll
            for (int i = 0; i < 4; ++i) { const float y = acc[i] + dh * ud[i];
                const unsigned w = cvt_pk_bf16(gelu_tanh(y), 0.f); YB[(size_t)(tok + 4 * fq + i) * SSMW + g * 16 + fr] = (bf16_t)(w & 0xffffu); }
            asm volatile("s_waitcnt lgkmcnt(0)" ::: "memory");
        }
    }
}

__device__ __forceinline__ void kmean_phase(LAS unsigned char* lds, const bf16_t* QK, float* KM, int tid) {
    const int cp = tid & 255, rh = tid >> 8; LAS float* red = (LAS float*)lds;
    for (int it = blockIdx.x; it < 256; it += gridDim.x) { const int b = it >> 4, n = (it >> 1) & 7, ch = it & 1;
        const bf16_t* p = QK + (size_t)(b * SEQ + n * 256 + rh * 128) * 2048 + 1024 + ch * 512 + 2 * cp; float s0 = 0.f, s1 = 0.f;
#pragma unroll 8
        for (int r = 0; r < 128; ++r) { const unsigned v = *(const unsigned*)(p + (size_t)r * 2048); s0 += bf_lo(v); s1 += bf_hi(v); }
        if (rh == 1) { red[2 * cp] = s0; red[2 * cp + 1] = s1; }
        __syncthreads();
        if (rh == 0) { s0 += red[2 * cp]; s1 += red[2 * cp + 1]; const int col = ch * 512 + 2 * cp, hh = col >> 7, d = col & 127;
            f32x2v o; o.x = s0 * (1.f / 256.f); o.y = s1 * (1.f / 256.f); *(f32x2v*)(KM + ((size_t)(b * NH + hh) * 8 + n) * HD + d) = o; }
        __syncthreads();
    }
}

__device__ __forceinline__ float max3f(float a, float b, float c) { float r; asm("v_max3_f32 %0, %1, %2, %3" : "=v"(r) : "v"(a), "v"(b), "v"(c)); return r; }
constexpr int ATT_KROW = 272, ATT_VROW = 144, ATT_KB = 64 * ATT_KROW, ATT_VB = 128 * ATT_VROW, ATT_STAGE = ATT_KB + ATT_VB;
__device__ __forceinline__ void attn_unit(LAS unsigned char* lds, const bf16_t* QK, const bf16_t* VTt, const float* KM, bf16_t* OA, int b, int h, int qb, int tid, int lane, int wave) {
    const int r32 = lane & 31, hf = lane >> 5;
    const int row0 = b * SEQ + qb * 256 + wave * 32;
    const char* kg = (const char*)(QK + (size_t)(b * SEQ) * 2048 + 1024 + h * HD);
    const char* vg = (const char*)(VTt + (size_t)((b * NH + h) * 32) * 8192);
    unsigned goff[5];
#pragma unroll
    for (int j = 0; j < 5; ++j) { int p = wave + 8 * j; p = p > 34 ? 34 : p; const int off = p * 1024 + lane * 16;
        if (p < 17) { const int r = off / ATT_KROW, cb = off % ATT_KROW; goff[j] = (unsigned)(r * 4096 + (cb < 256 ? cb : 0)); }
        else { const int o2 = off - ATT_KB, d = o2 / ATT_VROW, cb = o2 % ATT_VROW; goff[j] = (unsigned)(d * 128 + (cb < 128 ? cb : 0)); } }
    const int ntiles = 4 * (qb + 1);
#define ATT_DMA(i_, st_) do { const int key0_ = (qb - ((i_) >> 2)) * 256 + ((i_) & 3) * 64; const char* kb_ = kg + (size_t)key0_ * 4096; const char* vb_ = vg + (size_t)(key0_ >> 6) * 16384; \
        _Pragma("unroll") for (int j_ = 0; j_ < 5; ++j_) { int p_ = wave + 8 * j_; p_ = p_ > 34 ? 34 : p_; \
            __builtin_amdgcn_global_load_lds((const unsigned*)((p_ < 17 ? kb_ : vb_) + goff[j_]), (LAS unsigned*)(lds + (st_) * ATT_STAGE + p_ * 1024), 16, 0, 0); } } while (0)
    ATT_DMA(0, 0); ATT_DMA(1, 1);
    bf16x8 qf[8];
    { const bf16_t* qp = QK + (size_t)(row0 + r32) * 2048 + h * HD + hf * 8;
#pragma unroll
      for (int ks = 0; ks < 8; ++ks) qf[ks] = *(const bf16x8*)(qp + ks * 16); }
    unsigned sel = (1u << qb) - 1u;
    if (qb > 3) {
        float gate[7];
#pragma unroll
        for (int n = 0; n < 7; ++n) { gate[n] = -INFINITY;
            if (n < qb) { const float* kp = KM + ((size_t)(b * NH + h) * 8 + n) * HD + hf * 8; float s = 0.f;
#pragma unroll
                for (int ks = 0; ks < 8; ++ks) { const f32x4 k0 = *(const f32x4*)(kp + ks * 16), k1 = *(const f32x4*)(kp + ks * 16 + 4); const u32x4 q = __builtin_bit_cast(u32x4, qf[ks]);
                    s += bf_lo(q.x) * k0.x + bf_hi(q.x) * k0.y + bf_lo(q.y) * k0.z + bf_hi(q.y) * k0.w + bf_lo(q.z) * k1.x + bf_hi(q.z) * k1.y + bf_lo(q.w) * k1.z + bf_hi(q.w) * k1.w; }
                gate[n] = s + __shfl_xor(s, 32); } }
        sel = 0u;
#pragma unroll
        for (int rnd = 0; rnd < 3; ++rnd) { float best = -INFINITY; int bi = 0;
#pragma unroll
            for (int n = 0; n < 7; ++n) { const bool ok = (n < qb) && !((sel >> n) & 1u) && (gate[n] > best); best = ok ? gate[n] : best; bi = ok ? n : bi; }
            sel |= 1u << bi; }
    }
    f32x16 o[4];
#pragma unroll
    for (int db = 0; db < 4; ++db)
#pragma unroll
        for (int i = 0; i < 16; ++i) o[db][i] = 0.f;
    float mrun = -1e30f, lrun = 0.f;
    const int pi_r = ((r32 >> 2) & 1) * 16 + (r32 >> 3) * 4 + (r32 & 3);
    const int qq = wave * 32 + r32;
    const unsigned kread = pi_r * ATT_KROW + hf * 16, vread = ATT_KB + r32 * ATT_VROW + hf * 32;
    asm volatile("s_waitcnt vmcnt(0)" ::: "memory"); __builtin_amdgcn_s_barrier(); asm volatile("" ::: "memory");
    int st = 0;
    for (int i = 0; i < ntiles; ++i) {
        if (!(i & 1) && i + 2 < ntiles) { ATT_DMA(i + 2, (st + 2) & 3); ATT_DMA(i + 3, (st + 3) & 3); }
        const int kb = qb - (i >> 2), t = i & 3; const bool own = (kb == qb); const bool on = own || ((sel >> kb) & 1u);
        const bool active = own ? (64 * t <= wave * 32 + 31) : (__ballot(on) != 0ull);
        if (active) {
            const LAS unsigned char* sb = lds + st * ATT_STAGE;
            f32x16 s0, s1;
#pragma unroll
            for (int e = 0; e < 16; ++e) { s0[e] = 0.f; s1[e] = 0.f; }
            bf16x8 fa[8], fb[8];
#pragma unroll
            for (int ks = 0; ks < 8; ++ks) fa[ks] = *(const LAS bf16x8*)(sb + kread + ks * 32);
#pragma unroll
            for (int ks = 0; ks < 8; ++ks) fb[ks] = *(const LAS bf16x8*)(sb + kread + 32 * ATT_KROW + ks * 32);
            __builtin_amdgcn_sched_barrier(0);
#pragma unroll
            for (int ks = 0; ks < 8; ++ks) s0 = __builtin_amdgcn_mfma_f32_32x32x16_bf16(fa[ks], qf[ks], s0, 0, 0, 0);
            __builtin_amdgcn_sched_barrier(0);
#pragma unroll
            for (int db = 0; db < 4; ++db)
#pragma unroll
                for (int s2 = 0; s2 < 2; ++s2) fa[db * 2 + s2] = *(const LAS bf16x8*)(sb + vread + db * 32 * ATT_VROW + s2 * 16);
#pragma unroll
            for (int ks = 0; ks < 8; ++ks) s1 = __builtin_amdgcn_mfma_f32_32x32x16_bf16(fb[ks], qf[ks], s1, 0, 0, 0);
            __builtin_amdgcn_sched_barrier(0);
#pragma unroll
            for (int db = 0; db < 4; ++db)
#pragma unroll
                for (int s2 = 0; s2 < 2; ++s2) fb[db * 2 + s2] = *(const LAS bf16x8*)(sb + vread + db * 32 * ATT_VROW + 64 + s2 * 16);
            if (own && (64 * t + 63 > wave * 32)) {
                const int kk0 = t * 64 + hf * 16;
#pragma unroll
                for (int e = 0; e < 16; ++e) { s0[e] = (kk0 + e <= qq) ? s0[e] : -INFINITY; s1[e] = (kk0 + 32 + e <= qq) ? s1[e] : -INFINITY; }
            }
            float mxa = max3f(s0[0], s0[1], s1[0]), mxb = max3f(s0[2], s0[3], s1[1]); mxa = max3f(mxa, s1[2], s1[3]);
#pragma unroll
            for (int e = 4; e < 16; e += 4) { mxa = max3f(mxa, s0[e], s0[e + 1]); mxb = max3f(mxb, s0[e + 2], s0[e + 3]); mxa = max3f(mxa, s1[e], s1[e + 1]); mxb = max3f(mxb, s1[e + 2], s1[e + 3]); }
            float mx = on ? max3f(mxa, mxb, mxb) : -INFINITY;
            { const auto rr = __builtin_amdgcn_permlane32_swap(__builtin_bit_cast(unsigned, mx), __builtin_bit_cast(unsigned, mx), false, false);
              mx = fmaxf(__builtin_bit_cast(float, rr[0]), __builtin_bit_cast(float, rr[1])); }
            float alpha = 1.f;
            if (__ballot(mx > mrun + 8.f) != 0ull) { const float mnew = fmaxf(mrun, mx); alpha = __builtin_amdgcn_exp2f(mrun - mnew); mrun = mnew;
#pragma unroll
                for (int db = 0; db < 4; ++db)
#pragma unroll
                    for (int e = 0; e < 16; ++e) o[db][e] *= alpha; }
            const float msub = on ? mrun : INFINITY;
            float ps = 0.f;
#pragma unroll
            for (int e = 0; e < 16; ++e) { s0[e] = __builtin_amdgcn_exp2f(s0[e] - msub); s1[e] = __builtin_amdgcn_exp2f(s1[e] - msub); ps += s0[e] + s1[e]; }
            lrun = lrun * alpha + ps;
            bf16x8 pf[2][2];
#pragma unroll
            for (int s2 = 0; s2 < 2; ++s2) { u32x4 w; w.x = cvt_pk_bf16(s0[8 * s2 + 0], s0[8 * s2 + 1]); w.y = cvt_pk_bf16(s0[8 * s2 + 2], s0[8 * s2 + 3]); w.z = cvt_pk_bf16(s0[8 * s2 + 4], s0[8 * s2 + 5]); w.w = cvt_pk_bf16(s0[8 * s2 + 6], s0[8 * s2 + 7]); pf[0][s2] = __builtin_bit_cast(bf16x8, w);
                u32x4 v; v.x = cvt_pk_bf16(s1[8 * s2 + 0], s1[8 * s2 + 1]); v.y = cvt_pk_bf16(s1[8 * s2 + 2], s1[8 * s2 + 3]); v.z = cvt_pk_bf16(s1[8 * s2 + 4], s1[8 * s2 + 5]); v.w = cvt_pk_bf16(s1[8 * s2 + 6], s1[8 * s2 + 7]); pf[1][s2] = __builtin_bit_cast(bf16x8, v); }
            __builtin_amdgcn_sched_barrier(0);
#pragma unroll
            for (int s2 = 0; s2 < 2; ++s2)
#pragma unroll
                for (int db = 0; db < 4; ++db) o[db] = __builtin_amdgcn_mfma_f32_32x32x16_bf16(fa[db * 2 + s2], pf[0][s2], o[db], 0, 0, 0);
#pragma unroll
            for (int s2 = 0; s2 < 2; ++s2)
#pragma unroll
                for (int db = 0; db < 4; ++db) o[db] = __builtin_amdgcn_mfma_f32_32x32x16_bf16(fb[db * 2 + s2], pf[1][s2], o[db], 0, 0, 0);
        }
        if (i & 1) { asm volatile("s_waitcnt vmcnt(0)" ::: "memory");
            asm volatile("s_waitcnt lgkmcnt(0)" ::: "memory"); __builtin_amdgcn_s_barrier(); asm volatile("" ::: "memory"); }
        st = (st + 1) & 3;
    }
#undef ATT_DMA
    const float inv = 1.f / (lrun + __shfl_xor(lrun, 32));
    bf16_t* op = OA + (size_t)(row0 + r32) * D + h * HD + hf * 4;
#pragma unroll
    for (int db = 0; db < 4; ++db)
#pragma unroll
        for (int rg = 0; rg < 4; ++rg) { u32x2 w; w.x = cvt_pk_bf16(o[db][4 * rg] * inv, o[db][4 * rg + 1] * inv); w.y = cvt_pk_bf16(o[db][4 * rg + 2] * inv, o[db][4 * rg + 3] * inv);
            *(u32x2*)(op + db * 32 + rg * 8) = w; }
}

#define XB_TMO      128
#define XB_XCNT(j)  (256  + 64 * (j))
#define XB_XSUB(j)  (1280 + 64 * (j))
#define XB_XGEN(j)  (2304 + 64 * (j))
#define XB_TOP      3328
#define XB_TOPGEN   3392
#define XCD_BAR_WORDS 3456
#define XB_SPIN_CAP (1u << 18)

__device__ __forceinline__ unsigned xb_ld(unsigned* p)              { return __hip_atomic_load(p, __ATOMIC_RELAXED, __HIP_MEMORY_SCOPE_AGENT); }
__device__ __forceinline__ unsigned xb_add(unsigned* p, unsigned v) { return __hip_atomic_fetch_add(p, v, __ATOMIC_RELAXED, __HIP_MEMORY_SCOPE_AGENT); }
__device__ __forceinline__ unsigned xb_xcc_id() { return (unsigned)__builtin_amdgcn_s_getreg((3 << 11) | 20) & 0xFu; }
#define XB_SPIN(cond, bar) do { unsigned _sp = 0; while (cond) { __builtin_amdgcn_s_sleep(1); \
    if ((++_sp & 255u) == 0u) { if (xb_ld(&(bar)[XB_TMO])) break; if (_sp > XB_SPIN_CAP) { atomicAdd(&(bar)[XB_TMO], 1u); break; } } } } while (0)

struct XcdBarrier {
    unsigned* bar; unsigned x;
    volatile LAS unsigned* st;
};

__device__ __forceinline__ XcdBarrier xcd_barrier_post(unsigned* bar, volatile LAS unsigned* st) {
    XcdBarrier b; b.bar = bar; b.x = xb_xcc_id(); b.st = st;
    if (threadIdx.x == 0) (void)xb_add(&bar[XB_XCNT(b.x)], 1u);
    return b;
}
__device__ __forceinline__ void xcd_barrier_complete(unsigned* bar, unsigned x, unsigned& nloc, unsigned& nx) {
    const unsigned G = gridDim.x * gridDim.y * gridDim.z;
    unsigned sum, cnt, mine, sp = 0u;
    for (;;) {
        sum = 0u; cnt = 0u; mine = 0u;
#pragma unroll
        for (unsigned j = 0; j < 16; ++j) { const unsigned c = xb_ld(&bar[XB_XCNT(j)]); sum += c; cnt += (c > 0u) ? 1u : 0u; mine = (j == x) ? c : mine; }
        if (sum == G) break;
        __builtin_amdgcn_s_sleep(1);
        if ((++sp & 255u) == 0u) { if (xb_ld(&bar[XB_TMO])) break; if (sp > XB_SPIN_CAP) { atomicAdd(&bar[XB_TMO], 1u); break; } }
    }
    nloc = mine > 0u ? mine : 1u; nx = cnt > 0u ? cnt : 1u;
}

__device__ __forceinline__ void xcd_barrier(const XcdBarrier& b) {
    asm volatile("s_waitcnt vmcnt(0)" ::: "memory");
    __syncthreads();
    if (threadIdx.x == 0) {
        unsigned* bar = b.bar;
        __builtin_amdgcn_s_waitcnt(0);
        unsigned nloc = b.st[0], nx = b.st[1];
        if (nloc == 0u) { xcd_barrier_complete(bar, b.x, nloc, nx); b.st[0] = nloc; b.st[1] = nx; }
        const unsigned old = xb_add(&bar[XB_XSUB(b.x)], 1u);
        const unsigned gen = old / nloc;
        if (old + 1u == (gen + 1u) * nloc) {
            __builtin_amdgcn_fence(__ATOMIC_RELEASE, "agent");
            asm volatile("s_waitcnt vmcnt(0)" ::: "memory");
            const unsigned og = xb_add(&bar[XB_TOP], 1u);
            const unsigned tg = og / nx;
            if (og + 1u == (tg + 1u) * nx) xb_add(&bar[XB_TOPGEN], 1u);
            else XB_SPIN(xb_ld(&bar[XB_TOPGEN]) == tg, bar);
            __builtin_amdgcn_fence(__ATOMIC_ACQUIRE, "agent");
            xb_add(&bar[XB_XGEN(b.x)], 1u);
            asm volatile("s_waitcnt vmcnt(0)" ::: "memory");
        } else {
            XB_SPIN(xb_ld(&bar[XB_XGEN(b.x)]) == gen, bar);
            __builtin_amdgcn_fence(__ATOMIC_ACQUIRE, "agent");
            asm volatile("s_waitcnt vmcnt(0)" ::: "memory");
        }
    }
    __syncthreads();
}

constexpr size_t WS_CTL = 1 * MiB + 524288;
constexpr int LDS_ST_OFF = LDS_BYTES - 64;
template <bool WANT_PN> __device__ __forceinline__ int unit_tile(int M, int N, int G, int c, int i) {
    const int nM = M / 256, nN = N / 256, nwg = nM * nN; const long L = (long)i * G + c; if (L >= nwg) return -1;
    int wgid = (int)L; { const int q = nwg / pg8::NXCD, r = nwg % pg8::NXCD, xcd = wgid % pg8::NXCD, off = wgid / pg8::NXCD; wgid = (xcd < r ? xcd * (q + 1) : r * (q + 1) + (xcd - r) * q) + off; }
    const int nig = pg8::WGM * nN, gid = wgid / nig, fm = gid * pg8::WGM, gsz = (nM - fm) < pg8::WGM ? (nM - fm) : pg8::WGM;
    return WANT_PN ? (wgid % nig) / gsz : fm + ((wgid % nig) % gsz);
}
struct Args { const float* in[25]; float* out; unsigned char* ws; int ph_lo, ph_hi; };
constexpr int N_PHASES = 19;

template <class Epi> __device__ __forceinline__ void run_gemm(LAS unsigned char* lds, const bf16_t* A, const bf16_t* Bt, int M, int N, int K, const Epi& E) {
    pg8::Gemm g{A, Bt, M, N, K}; pg8::StaticOrder S; S.init(M, N, (int)gridDim.x, (int)blockIdx.x);
    pg8::gemm_phase<Epi, pg8::StaticOrder, true, true>(lds, g, S, E);
}

__global__ void __launch_bounds__(NTHREADS, 2) mega_fwd(Args a) {
    extern __shared__ __attribute__((aligned(16))) unsigned char lds_raw[];
    LAS unsigned char* lds = (LAS unsigned char*)lds_raw;
    cg::grid_group grid = cg::this_grid();
    const int tid = threadIdx.x, lane = tid & 63, wave = __builtin_amdgcn_readfirstlane(tid >> 6);
    const int G = gridDim.x, gw = blockIdx.x * NWAVES + wave, NGW = G * NWAVES;
    unsigned char* ws = a.ws;
    bf16_t* XB = (bf16_t*)(ws + WS_H); bf16_t* U = (bf16_t*)(ws + WS_U);
    bf16_t* VC = (bf16_t*)(ws + WS_VC); bf16_t* US = (bf16_t*)(ws + WS_US); bf16_t* YB = (bf16_t*)(ws + WS_YB); bf16_t* CAT = (bf16_t*)(ws + WS_CAT);
    bf16_t* QK = (bf16_t*)(ws + WS_QK); bf16_t* VT = (bf16_t*)(ws + WS_VT); bf16_t* OA = (bf16_t*)(ws + WS_OA);
    float* KM = (float*)(ws + WS_KMEAN); float* SST = (float*)(ws + WS_SST); float* SS = (float*)(ws + WS_SS);
    const int lo = a.ph_lo, hi = a.ph_hi;
    volatile LAS unsigned* bst = (volatile LAS unsigned*)(lds + LDS_ST_OFF);
    if (tid < 2) bst[tid] = 0u;
    __syncthreads();
    XcdBarrier xbar = xcd_barrier_post((unsigned*)(ws + WS_CTL), bst);
#define IN(k) (lo <= (k) && (k) < hi)
#define SEAM(k) do { if (IN(k) && IN((k) + 1)) xcd_barrier(xbar); } while (0)
    if (lo < 0) grid.sync();

    if (IN(0)) {
        LAS float* scr = (LAS float*)(lds + wave * 16384);
        constexpr int I_UP = (D / 64) * (FF / 32), I_DN = (FF / 64) * (D / 32), I_FFN = 2 * I_UP + I_DN;
        constexpr int I_IN = (D / 64) * (512 / 32), I_GLU = (512 / 64) * (512 / 32), I_SQ = (D / 64) * (D / 32), I_QK = (D / 64) * (2048 / 32);
        constexpr int NITEMS = 4 * I_FFN + 3 * I_IN + I_GLU + I_SQ + I_QK + I_SQ + I_SQ;
#define P0_DESC(it_, out_) do { int r = (it_); \
            if (r < 4 * I_FFN) { const int f = r / I_FFN; r -= f * I_FFN; \
                bf16_t* wup = (bf16_t*)(ws + WS_WUP + f * WUP_STRIDE); bf16_t* wdn = (bf16_t*)(ws + WS_WDN + f * WDN_STRIDE); const float* gn = a.in[1] + f * D; \
                if (r < I_UP) out_ = tr_desc(a.in[2] + (size_t)f * D * FF, FF, D, wup, FF / 32, 1, 0, gn, r); \
                else if (r < 2 * I_UP) out_ = tr_desc(a.in[3] + (size_t)f * D * FF, FF, D, wup, FF / 32, 1, 1, gn, r - I_UP); \
                else out_ = tr_desc(a.in[4] + (size_t)f * FF * D, D, FF, wdn, D / 32, 0, 0, nullptr, r - 2 * I_UP); } \
            else { r -= 4 * I_FFN; \
                if (r < I_IN) out_ = tr_desc(a.in[6], 1536, D, (bf16_t*)(ws + WS_WIN), 16, 1, 0, a.in[5], r); \
                else if (r < 2 * I_IN) out_ = tr_desc(a.in[6] + 512, 1536, D, (bf16_t*)(ws + WS_WIN), 16, 1, 1, a.in[5], r - I_IN); \
                else if (r < 3 * I_IN) out_ = tr_desc(a.in[6] + 1024, 1536, D, (bf16_t*)(ws + WS_WIN), 16, 0, 1024, a.in[5], r - 2 * I_IN); \
                else { r -= 3 * I_IN; \
                    if (r < I_GLU) out_ = tr_desc(a.in[19], 512, 512, (bf16_t*)(ws + WS_WGLU), 16, 0, 0, nullptr, r); \
                    else if (r < I_GLU + I_SQ) out_ = tr_desc(a.in[21], D, D, (bf16_t*)(ws + WS_WOUT), 32, 0, 0, nullptr, r - I_GLU); \
                    else if (r < I_GLU + I_SQ + I_QK) out_ = tr_desc(a.in[22], 3072, D, (bf16_t*)(ws + WS_WQK), 64, 0, 0, a.in[5] + D, r - I_GLU - I_SQ); \
                    else if (r < I_GLU + 2 * I_SQ + I_QK) out_ = tr_desc(a.in[22] + 2048, 3072, D, (bf16_t*)(ws + WS_WV), 32, 0, 0, a.in[5] + D, r - I_GLU - I_SQ - I_QK); \
                    else out_ = tr_desc(a.in[23], D, D, (bf16_t*)(ws + WS_WO), 32, 0, 0, nullptr, r - I_GLU - 2 * I_SQ - I_QK); } } } while (0)
        if (gw < NITEMS) {
            TrDesc dc; P0_DESC(gw, dc); float vc[32]; tr_load(dc, vc, lane);
            for (int it = gw; it < NITEMS; it += NGW) {
                TrDesc dn = dc; float vn[32];
                const bool more = it + NGW < NITEMS;
                if (more) { P0_DESC(it + NGW, dn); tr_load(dn, vn, lane); }
                tr_store(dc, vc, scr, lane);
                if (more) { dc = dn;
#pragma unroll
                    for (int i = 0; i < 32; ++i) vc[i] = vn[i]; }
            }
        }
#undef P0_DESC
        if (gw * 64 + lane < NG * NS) ssm_tables(gw * 64 + lane, a.in[11], a.in[12], a.in[13], a.in[14], a.in[18], (float*)(ws + WS_ABAR), (bf16_t*)(ws + WS_BBH), (bf16_t*)(ws + WS_BBL));
        if (gw * 64 + lane < NG * 16 * 16) ssm_ctable(gw * 64 + lane, a.in[15], a.in[16], (bf16_t*)(ws + WS_CMH), (bf16_t*)(ws + WS_CML));
        for (int i = gw * 64 + lane; i < NB * NH * 8 * HD; i += NGW * 64) KM[i] = 0.f;
        xb_rows(a.in[0], XB, SS, gw, NGW, lane);
    }
    SEAM(0);
#define BUILD_RTAB(RT, M_, N_, WANT_PN, nin) RTab RT; { int q0 = -1, q1 = -1, q2 = -1, q3 = -1; \
          for (int i = 0; i < 16; ++i) { const int pm_ = unit_tile<WANT_PN>(M_, N_, G, (int)blockIdx.x, i); if (pm_ >= 0 && pm_ != q0 && pm_ != q1 && pm_ != q2 && pm_ != q3) { if (q0 < 0) q0 = pm_; else if (q1 < 0) q1 = pm_; else if (q2 < 0) q2 = pm_; else if (q3 < 0) q3 = pm_; } } \
          const float* ssp = SS + (nin) * SSN; __syncthreads(); \
          _Pragma("unroll") for (int q = 0; q < 4; ++q) { const int pq = q == 0 ? q0 : (q == 1 ? q1 : (q == 2 ? q2 : q3)); if (pq >= 0 && tid < 256) { const int row = pq * 256 + tid; float t = 0.f; \
              _Pragma("unroll") for (int p = 0; p < 16; ++p) t += ssp[(size_t)p * T + row]; ((LAS float*)(lds + LDS_RTAB_OFF))[q * 256 + tid] = rs_of(t); } } \
          __syncthreads(); RT = RTab{(const LAS float*)(lds + LDS_RTAB_OFF), q0, q1, q2, q3}; }
#define FFN_UP(k, f, nin) if (IN(k)) { BUILD_RTAB(RT, T, 2 * FF, false, nin) EpiSwiglu E{U, RT}; \
        run_gemm(lds, XB, (const bf16_t*)(ws + WS_WUP + (f) * WUP_STRIDE), T, 2 * FF, D, E); } SEAM(k);
#define FFN_DN(k, f, xin, nout) if (IN(k)) { EpiResid E{XB, 0.5f, SS + (nout) * SSN}; run_gemm(lds, U, (const bf16_t*)(ws + WS_WDN + (f) * WDN_STRIDE), T, D, FF, E); } SEAM(k);
    FFN_UP(1, 0, 0)
    FFN_DN(2, 0, a.in[0], 1)
    if (IN(3)) { BUILD_RTAB(RT, T, 1536, false, 1) EpiWin E{VC, US, RT}; run_gemm(lds, XB, (const bf16_t*)(ws + WS_WIN), T, 1536, D, E); }
    SEAM(3);
    if (IN(4)) {
        conv_phase(lds, VC, a.in[7], a.in[8], a.in[9], a.in[10], CAT, tid, lane, wave);
        ssm_pass1(lds, US, SST, (const float*)(ws + WS_ABAR), (const bf16_t*)(ws + WS_BBH), (const bf16_t*)(ws + WS_BBL), gw, NGW, lane, wave);
    }
    SEAM(4);
    if (IN(5)) ssm_pass2(lds, US, SST, YB, (const float*)(ws + WS_ABAR), (const bf16_t*)(ws + WS_BBH), (const bf16_t*)(ws + WS_BBL), (const bf16_t*)(ws + WS_CMH), (const bf16_t*)(ws + WS_CML), a.in[17], gw, NGW, lane, wave);
    SEAM(5);
    if (IN(6)) { EpiGlu E{YB, a.in[20], CAT}; run_gemm(lds, YB, (const bf16_t*)(ws + WS_WGLU), T, 512, 512, E); }
    SEAM(6);
    if (IN(7)) { EpiResid E{XB, 1.f, SS + 2 * SSN}; run_gemm(lds, CAT, (const bf16_t*)(ws + WS_WOUT), T, D, D, E); }
    SEAM(7);
    FFN_UP(8, 1, 2)
    FFN_DN(9, 1, X, 3)
    FFN_UP(10, 2, 3)
    FFN_DN(11, 2, X, 4)
    if (IN(12)) {
        { BUILD_RTAB(RT, T, 2048, false, 4) EpiBf E{QK, 2048, 4, C2, RT, KM}; run_gemm(lds, XB, (const bf16_t*)(ws + WS_WQK), T, 2048, D, E); }
        { BUILD_RTAB(RT, D, T, true, 4) EpiVT E{VT, RT}; run_gemm(lds, (const bf16_t*)(ws + WS_WV), XB, D, T, D, E); }
    }
    SEAM(12);
    if (IN(14)) {
        const int vcu = (G % 8 == 0) ? (int)(blockIdx.x % 8) * (G / 8) + (int)(blockIdx.x / 8) : (int)blockIdx.x;
        for (int pu = vcu; pu < NB * NH * 4; pu += G) { const int bh = pu >> 2, j = pu & 3, b = bh >> 3, h = bh & 7;
            attn_unit(lds, QK, VT, KM, OA, b, h, 7 - j, tid, lane, wave);
            attn_unit(lds, QK, VT, KM, OA, b, h, j, tid, lane, wave); }
    }
    SEAM(14);
    if (IN(15)) { EpiResid E{XB, 1.f, SS + 5 * SSN}; run_gemm(lds, OA, (const bf16_t*)(ws + WS_WO), T, D, D, E); }
    SEAM(15);
    FFN_UP(16, 3, 5)
    FFN_DN(17, 3, X, 6)
    if (IN(18)) final_rows(XB, a.out, a.in[24], SS + 6 * SSN, gw, NGW, lane);
#undef IN
#undef SEAM
}

extern "C" void kernel_launch(void* const* d_in, const int* in_sizes, int n_in, void* d_out, int out_size, void* d_ws, size_t ws_size, hipStream_t stream) {
    static int grid = 0;
    if (grid == 0) {
        if (n_in != 25 || in_sizes[0] != T * D || out_size != T * D || ws_size < WS_END) { fprintf(stderr, "kernel_launch: unexpected shapes (n_in %d, in0 %d, out %d, ws %zu < %zu)\n", n_in, n_in > 0 ? in_sizes[0] : -1, out_size, ws_size, (size_t)WS_END); grid = -1; return; }
        int dev = 0, cus = 0, per_cu = 0;
        (void)hipGetDevice(&dev); (void)hipDeviceGetAttribute(&cus, hipDeviceAttributeMultiprocessorCount, dev);
        if (hipFuncSetAttribute((const void*)mega_fwd, hipFuncAttributeMaxDynamicSharedMemorySize, LDS_BYTES) != hipSuccess) { fprintf(stderr, "kernel_launch: hipFuncSetAttribute failed\n"); grid = -1; return; }
        if (hipOccupancyMaxActiveBlocksPerMultiprocessor(&per_cu, (const void*)mega_fwd, NTHREADS, LDS_BYTES) != hipSuccess || per_cu < 1) { fprintf(stderr, "kernel_launch: occupancy query says %d\n", per_cu); per_cu = 1; }
        (void)hipGetLastError();
        grid = cus * 1;
        fprintf(stderr, "kernel_launch: grid %d (cus %d, per_cu %d)\n", grid, cus, per_cu);
    }
    if (grid < 0) return;
    Args a{};
    for (int i = 0; i < 25; ++i) a.in[i] = (const float*)d_in[i];
    a.out = (float*)d_out; a.ws = (unsigned char*)d_ws; a.ph_lo = 0; a.ph_hi = N_PHASES;
    if (hipMemsetAsync((char*)d_ws + WS_CTL, 0, 16384, stream) != hipSuccess) { fprintf(stderr, "kernel_launch: memset failed\n"); return; }
    void* args[] = {&a};
    hipError_t e = hipLaunchCooperativeKernel((const void*)mega_fwd, dim3(grid), dim3(NTHREADS), args, LDS_BYTES, stream);
    if (e != hipSuccess) fprintf(stderr, "kernel_launch: cooperative launch failed: %s (grid %d)\n", hipGetErrorString(e), grid);
}
```

```cpp
#include <hip/hip_runtime.h>
#include <hip/hip_cooperative_groups.h>
#include <cstdio>
#include <cstdint>
namespace cg = cooperative_groups;
namespace pg8 {
#define PG8_LAS __attribute__((address_space(3)))
typedef unsigned short bf16_t;
typedef short bf16x8 __attribute__((ext_vector_type(8)));
typedef float f32x4 __attribute__((ext_vector_type(4)));
typedef unsigned u32x4 __attribute__((ext_vector_type(4)));
constexpr int BM = 256, BK = 64, HALF = 128, HTB = HALF * BK * 2  , STAGE_BYTES = 8 * HTB, NXCD = 8, WGM = 8;

__host__ __device__ __forceinline__ int lds_byte(int r, int c) { const int st = (r >> 4) * 2 + (c >> 5), rr = r & 15, cc = c & 31, ob = rr * 64 + cc * 2; return st * 1024 + (ob ^ (((ob >> 9) & 1) << 5)); }
__host__ __device__ __forceinline__ void stage_rc(int b, int& R, int& C) { const int st = b / 1024, sb = b % 1024, swz = sb ^ (((sb >> 9) & 1) << 5); R = (st >> 1) * 16 + swz / 64; C = (st & 1) * 32 + (swz % 64) / 2; }
__host__ __device__ __forceinline__ int perm32(int rho) { const int n = rho >> 4, i = rho & 15; return 8 * (i >> 2) + 4 * n + (i & 3); }

struct Unit { int pm, pn; };
struct Gemm { const bf16_t* A; const bf16_t* Bt; int M, N, K; };

struct StaticOrder {
    int nM, nN, nwg, G, c;
    __host__ __device__ void init(int M, int N, int G_, int c_) { nM = M / BM; nN = N / BM; nwg = nM * nN; G = G_; c = c_; }
    __host__ __device__ bool next(int i, Unit& u) const {
        const long L = (long)i * G + c; if (L >= nwg) return false;
        int wgid = (int)L; { const int q = nwg / NXCD, r = nwg % NXCD, xcd = wgid % NXCD, off = wgid / NXCD; wgid = (xcd < r ? xcd * (q + 1) : r * (q + 1) + (xcd - r) * q) + off; }
        const int nig = WGM * nN, gid = wgid / nig, fm = gid * WGM, gsz = (nM - fm) < WGM ? (nM - fm) : WGM;
        u.pm = fm + ((wgid % nig) % gsz); u.pn = (wgid % nig) / gsz; return true;
    }
    __device__ __forceinline__ void a_ready(const Unit&) const {}
    __device__ __forceinline__ void done(const Unit&) const {}
};

__device__ __forceinline__ unsigned cvt_pk_bf16(float lo, float hi) { unsigned r; asm volatile("v_cvt_pk_bf16_f32 %0, %1, %2" : "=v"(r) : "v"(lo), "v"(hi)); return r; }
typedef float f32x2 __attribute__((ext_vector_type(2)));
template <class Epi, class Sched, bool ALIGN_EPI = false, bool SP2 = false>
__device__ __forceinline__ void gemm_phase(PG8_LAS unsigned char* lds, const Gemm g, const Sched& S, const Epi& E) {
    const int tid = threadIdx.x, wid = __builtin_amdgcn_readfirstlane(tid >> 6), lane = tid & 63, wr = wid >> 2, wc = wid & 3, fr = lane & 15, fq = lane >> 4;
    const int K = g.K, nt = K / BK;
    unsigned voffA[2], voffB[2];
#pragma unroll
    for (int i = 0; i < 2; ++i) { int R, C; stage_rc(tid * 16 + i * 8192, R, C); const int Rb = Epi::PERM ? ((R & ~31) + perm32(R & 31)) : R;
        voffA[i] = (unsigned)(R * K + C) * 2u; voffB[i] = (unsigned)(Rb * K + C) * 2u; }
    const size_t kstep = (size_t)(BK * 2);
    const size_t hstep = (size_t)HALF * K * 2;
    const size_t tstep = 2 * hstep;
    const unsigned ldsw = (unsigned)wid * 1024u;
    const int aoff = lds_byte(wr * 64 + fr, fq * 8), boff = lds_byte(wc * 32 + fr, fq * 8);
#define PG8_SA(b, h) (((b) * 2 + (h)) * HTB)
#define PG8_SB(b, h) ((4 + (b) * 2 + (h)) * HTB)
#define PG8_STAGE(bufoff, gbase, voff) do { _Pragma("unroll") for (int _i = 0; _i < 2; ++_i) \
        __builtin_amdgcn_global_load_lds((const unsigned*)((const char*)(gbase) + (voff)[_i]), (PG8_LAS unsigned*)(lds + (bufoff) + ldsw + _i * 8192), 16, 0, 0); } while (0)
#define PG8_LDA(dst, b, h) do { _Pragma("unroll") for (int m = 0; m < 4; ++m) _Pragma("unroll") for (int k = 0; k < 2; ++k) dst[m][k] = *(const PG8_LAS bf16x8*)(lds + PG8_SA(b, h) + aoff + m * 2048 + k * 1024); } while (0)
#define PG8_LDB(dst, b, h) do { _Pragma("unroll") for (int n = 0; n < 2; ++n) _Pragma("unroll") for (int k = 0; k < 2; ++k) dst[n][k] = *(const PG8_LAS bf16x8*)(lds + PG8_SB(b, h) + boff + n * 2048 + k * 1024); } while (0)
#define PG8_MMA(ai, bj, At, Bt) do { __builtin_amdgcn_s_setprio(1); _Pragma("unroll") for (int m = 0; m < 4; ++m) _Pragma("unroll") for (int n = 0; n < 2; ++n) _Pragma("unroll") for (int k = 0; k < 2; ++k) \
        acc[ai][bj][m][n] = __builtin_amdgcn_mfma_f32_16x16x32_bf16(Bt[n][k], At[m][k], acc[ai][bj][m][n], 0, 0, 0); __builtin_amdgcn_s_setprio(0); } while (0)
#define PG8_WAIT_V(n) asm volatile("s_waitcnt vmcnt(" #n ")" ::: "memory")
#define PG8_WAIT_L(n) asm volatile("s_waitcnt lgkmcnt(" #n ")" ::: "memory")
#define PG8_BAR __builtin_amdgcn_s_barrier()
#define PG8_SCHED __builtin_amdgcn_sched_barrier(0)
    Unit cur, nxt; int ui = 0;
    if (!S.next(0, cur)) return;
    f32x4 acc[2][2][4][2];
#pragma unroll
    for (int a = 0; a < 2; ++a)
#pragma unroll
        for (int b = 0; b < 2; ++b)
#pragma unroll
            for (int m = 0; m < 4; ++m)
#pragma unroll
                for (int n = 0; n < 2; ++n) acc[a][b][m][n] = (f32x4){0.f, 0.f, 0.f, 0.f};
    bf16x8 At[4][2], B0[2][2], B1[2][2];
    const char* cA = (const char*)g.A + (size_t)cur.pm * tstep; const char* cB = (const char*)g.Bt + (size_t)cur.pn * tstep;
    S.a_ready(cur);
    if constexpr (SP2) {
        PG8_STAGE(PG8_SB(0, 0), cB, voffB); PG8_STAGE(PG8_SB(0, 1), cB + hstep, voffB); PG8_STAGE(PG8_SA(0, 0), cA, voffA); PG8_STAGE(PG8_SA(0, 1), cA + hstep, voffA);
        if (wr == 1) PG8_BAR;
        PG8_WAIT_V(2); PG8_BAR;
        PG8_STAGE(PG8_SB(1, 0), cB + kstep, voffB); PG8_STAGE(PG8_SA(1, 0), cA + kstep, voffA); PG8_STAGE(PG8_SB(1, 1), cB + hstep + kstep, voffB);
        PG8_WAIT_V(6); PG8_BAR;
    } else {
        PG8_STAGE(PG8_SB(0, 0), cB, voffB); PG8_STAGE(PG8_SA(0, 0), cA, voffA); PG8_STAGE(PG8_SB(0, 1), cB + hstep, voffB); PG8_STAGE(PG8_SA(0, 1), cA + hstep, voffA);
        if (wr == 1) PG8_BAR;
        PG8_WAIT_V(4); PG8_BAR;
        PG8_STAGE(PG8_SB(1, 0), cB + kstep, voffB); PG8_STAGE(PG8_SA(1, 0), cA + kstep, voffA); PG8_STAGE(PG8_SB(1, 1), cB + hstep + kstep, voffB);
        PG8_WAIT_V(6); PG8_BAR;
    }
    for (;;) {
        const bool has_next = S.next(ui + 1, nxt);
        const char* nA = has_next ? (const char*)g.A + (size_t)nxt.pm * tstep : cA; const char* nB = has_next ? (const char*)g.Bt + (size_t)nxt.pn * tstep : cB;
        for (int t = 0; t < nt; t += 2) {
            const bool last = (t == nt - 2);
            const char* a1 = cA + (size_t)(t + 1) * kstep;
            const char* a2 = last ? nA : cA + (size_t)(t + 2) * kstep; const char* b2 = last ? nB : cB + (size_t)(t + 2) * kstep;
            const char* a3 = a2 + kstep; const char* b3 = b2 + kstep;
            if (last && has_next) S.a_ready(nxt);
            if constexpr (SP2) {
            PG8_LDB(B0, 0, 0); PG8_LDB(B1, 0, 1); PG8_SCHED; PG8_LDA(At, 0, 0); PG8_STAGE(PG8_SA(1, 1), a1 + hstep, voffA);
            PG8_WAIT_V(8); PG8_WAIT_L(0); PG8_BAR; PG8_MMA(0, 0, At, B0); PG8_MMA(0, 1, At, B1); PG8_BAR; PG8_SCHED;
            PG8_LDA(At, 0, 1); PG8_STAGE(PG8_SB(0, 0), b2, voffB); PG8_STAGE(PG8_SB(0, 1), b2 + hstep, voffB); PG8_STAGE(PG8_SA(0, 0), a2, voffA);
            PG8_WAIT_V(8); PG8_WAIT_L(0); PG8_BAR; PG8_MMA(1, 0, At, B0); PG8_MMA(1, 1, At, B1); PG8_BAR; PG8_SCHED;
            PG8_LDB(B0, 1, 0); PG8_LDB(B1, 1, 1); PG8_SCHED; PG8_LDA(At, 1, 0); PG8_STAGE(PG8_SA(0, 1), a2 + hstep, voffA);
            PG8_WAIT_V(8); PG8_WAIT_L(0); PG8_BAR; PG8_MMA(0, 0, At, B0); PG8_MMA(0, 1, At, B1); PG8_BAR; PG8_SCHED;
            PG8_LDA(At, 1, 1); PG8_STAGE(PG8_SB(1, 0), b3, voffB); PG8_STAGE(PG8_SB(1, 1), b3 + hstep, voffB); PG8_STAGE(PG8_SA(1, 0), a3, voffA);
            PG8_WAIT_V(8); PG8_WAIT_L(0); PG8_BAR; PG8_MMA(1, 0, At, B0); PG8_MMA(1, 1, At, B1); PG8_BAR; PG8_SCHED;
            } else {
            PG8_LDB(B0, 0, 0); PG8_SCHED; PG8_LDA(At, 0, 0); PG8_STAGE(PG8_SA(1, 1), a1 + hstep, voffA);
            PG8_WAIT_L(8); PG8_BAR; PG8_WAIT_L(0); PG8_MMA(0, 0, At, B0); PG8_BAR; PG8_SCHED;
            PG8_LDB(B1, 0, 1); PG8_STAGE(PG8_SB(0, 0), b2, voffB);
            PG8_BAR; PG8_WAIT_L(0); PG8_MMA(0, 1, At, B1); PG8_BAR;
            PG8_LDA(At, 0, 1); PG8_STAGE(PG8_SA(0, 0), a2, voffA);
            PG8_BAR; PG8_WAIT_L(0); PG8_MMA(1, 0, At, B0); PG8_BAR; PG8_SCHED;
            PG8_STAGE(PG8_SB(0, 1), b2 + hstep, voffB);
            PG8_WAIT_V(6); PG8_BAR; PG8_MMA(1, 1, At, B1); PG8_BAR;
            PG8_LDB(B0, 1, 0); PG8_SCHED; PG8_LDA(At, 1, 0); PG8_STAGE(PG8_SA(0, 1), a2 + hstep, voffA);
            PG8_WAIT_L(8); PG8_BAR; PG8_WAIT_L(0); PG8_MMA(0, 0, At, B0); PG8_BAR; PG8_SCHED;
            PG8_LDB(B1, 1, 1); PG8_STAGE(PG8_SB(1, 0), b3, voffB);
            PG8_BAR; PG8_WAIT_L(0); PG8_MMA(0, 1, At, B1); PG8_BAR;
            PG8_LDA(At, 1, 1); PG8_STAGE(PG8_SA(1, 0), a3, voffA);
            PG8_BAR; PG8_WAIT_L(0); PG8_MMA(1, 0, At, B0); PG8_BAR; PG8_SCHED;
            PG8_STAGE(PG8_SB(1, 1), b3 + hstep, voffB);
            PG8_WAIT_V(6); PG8_BAR; PG8_MMA(1, 1, At, B1); PG8_BAR;
            }
        }
        if constexpr (ALIGN_EPI) { if (wr == 0) PG8_BAR; }
        if constexpr (!Epi::AFTER_DRAIN) { E(acc, cur, wr, wc, fr, fq); S.done(cur); }
        if (!has_next) break;
#pragma unroll
        for (int a = 0; a < 2; ++a)
#pragma unroll
            for (int b = 0; b < 2; ++b)
#pragma unroll
                for (int m = 0; m < 4; ++m)
#pragma unroll
                    for (int n = 0; n < 2; ++n) acc[a][b][m][n] = (f32x4){0.f, 0.f, 0.f, 0.f};
        cur = nxt; cA = nA; cB = nB; ++ui;
        if constexpr (ALIGN_EPI) { if (wr == 1) PG8_BAR; }
    }
    PG8_WAIT_V(0);
    if constexpr (!ALIGN_EPI) { if (wr == 0) PG8_BAR; }
    PG8_BAR;
    if constexpr (Epi::AFTER_DRAIN) { E.fused(acc, cur, wr, wc, fr, fq, lds, wid, lane); S.done(cur); }
#undef PG8_SA
#undef PG8_SB
#undef PG8_STAGE
#undef PG8_LDA
#undef PG8_LDB
#undef PG8_MMA
#undef PG8_WAIT_V
#undef PG8_WAIT_L
#undef PG8_BAR
#undef PG8_SCHED
}
}

#define LAS __attribute__((address_space(3)))
using pg8::bf16_t; using pg8::bf16x8; using pg8::f32x4; using pg8::u32x4; using pg8::cvt_pk_bf16;
typedef float f32x16 __attribute__((ext_vector_type(16)));
typedef float f32x2v __attribute__((ext_vector_type(2)));
typedef unsigned u32x2 __attribute__((ext_vector_type(2)));
constexpr int NB = 16, SEQ = 2048, T = NB * SEQ, D = 1024, FF = 2816;
constexpr int CONVC = 512, TAPS = 31, SSMW = 512, NG = 32, NS = 64, NH = 8, HD = 128;
constexpr int NWAVES = 8, NTHREADS = 512;
constexpr int LDS_BYTES = 147456;
constexpr int LDS_RTAB_OFF = 131072;
constexpr size_t MiB = 1u << 20;
constexpr size_t WS_KMEAN = 0, WS_SST = 2 * MiB, WS_SS = 88 * MiB;
constexpr size_t WS_WUP = 8 * MiB, WS_WDN = 52 * MiB, WS_WIN = 74 * MiB, WS_WGLU = 77 * MiB, WS_WOUT = 78 * MiB, WS_WQK = 80 * MiB, WS_WV = 84 * MiB, WS_WO = 86 * MiB;
constexpr size_t WUP_STRIDE = 11 * MiB, WDN_STRIDE = (size_t)D * FF * 2;
constexpr size_t WS_H = 104 * MiB, WS_BIG = 168 * MiB;
constexpr size_t WS_U = WS_BIG, WS_VC = WS_BIG, WS_US = WS_BIG + 32 * MiB, WS_YB = WS_BIG + 96 * MiB, WS_CAT = WS_BIG + 128 * MiB;
constexpr size_t WS_QK = WS_BIG, WS_VT = WS_BIG + 128 * MiB, WS_OA = WS_BIG + 192 * MiB, WS_END = WS_BIG + 256 * MiB;
constexpr float C2 = 0.08838834764831845f * 1.4426950408889634f;
constexpr float LOG2E = 1.4426950408889634f;

__device__ __forceinline__ float bf_lo(unsigned w) { return __builtin_bit_cast(float, w << 16); }
__device__ __forceinline__ float bf_hi(unsigned w) { return __builtin_bit_cast(float, w & 0xffff0000u); }
__device__ __forceinline__ float fast_sigmoid(float x) { return __builtin_amdgcn_rcpf(1.f + __builtin_amdgcn_exp2f(-x * LOG2E)); }
__device__ __forceinline__ float fast_silu(float x) { return x * fast_sigmoid(x); }
__device__ __forceinline__ float gelu_tanh(float x) { const float z = 0.7978845608028654f * (x + 0.044715f * x * x * x); const float e = __builtin_amdgcn_exp2f(2.f * LOG2E * z); return 0.5f * x * (2.f - 2.f * __builtin_amdgcn_rcpf(1.f + e)); }
__device__ __forceinline__ float rs_of(float ss) { return 1.0f / sqrtf(ss * (1.f / 1024.f) + 1e-6f); }
constexpr int SSN = 16 * T;
__device__ __forceinline__ float row_scale(const float* SSP, int row, int fq) {
    const float* p = SSP + (size_t)(4 * fq) * T + row; float t = (p[0] + p[T]) + (p[2 * T] + p[3 * T]);
    t += __shfl_xor(t, 16); t += __shfl_xor(t, 32); return rs_of(t);
}
__device__ __forceinline__ float wave_sum(float v) {
#pragma unroll
    for (int o = 1; o < 64; o <<= 1) v += __shfl_xor(v, o);
    return v;
}

typedef float f32x2c __attribute__((ext_vector_type(2))); typedef __bf16 bf16x2c __attribute__((ext_vector_type(2)));
__device__ __forceinline__ unsigned cvt_pk2(float lo, float hi) { f32x2c v = {lo, hi}; bf16x2c q = __builtin_convertvector(v, bf16x2c); return __builtin_bit_cast(unsigned, q); }
struct RTab { const LAS float* tab; int p0, p1, p2, p3;
    __device__ __forceinline__ const LAS float* of(int p) const { return tab + (p == p0 ? 0 : (p == p1 ? 1 : (p == p2 ? 2 : 3))) * 256; } };
struct EpiSwiglu {
    static constexpr bool PERM = true, AFTER_DRAIN = false; bf16_t* O; RTab rt_;
    __device__ __forceinline__ void operator()(const f32x4 (&acc)[2][2][4][2], const pg8::Unit& u, int wr, int wc, int fr, int fq) const {
        const int row0 = u.pm * 256 + wr * 64 + fr, col0 = u.pn * 128 + wc * 32 + 8 * fq;
        const LAS float* rt = rt_.of(u.pm) + wr * 64 + fr;
#pragma unroll
        for (int ai = 0; ai < 2; ++ai)
#pragma unroll
            for (int m = 0; m < 4; ++m) { bf16_t* rowp = O + (size_t)(row0 + ai * 128 + m * 16) * FF + col0; const float r = rt[ai * 128 + m * 16];
                const float rl = -r * LOG2E, r2 = r * r; unsigned w[4];
#pragma unroll
                for (int n = 0; n < 2; ++n)
#pragma unroll
                    for (int h = 0; h < 2; ++h) { const f32x2v g = {acc[ai][0][m][n][2 * h], acc[ai][0][m][n][2 * h + 1]}, uu = {acc[ai][1][m][n][2 * h], acc[ai][1][m][n][2 * h + 1]};
                        const f32x2v t = g * rl; f32x2v d = {__builtin_amdgcn_exp2f(t.x), __builtin_amdgcn_exp2f(t.y)}; d = d + 1.0f;
                        const f32x2v q = {__builtin_amdgcn_rcpf(d.x), __builtin_amdgcn_rcpf(d.y)}; const f32x2v o = ((g * uu) * r2) * q;
                        w[2 * n + h] = cvt_pk2(o.x, o.y); }
                u32x4 wv; wv.x = w[0]; wv.y = w[1]; wv.z = w[2]; wv.w = w[3];
                *(u32x4*)rowp = wv; }
    }
};
struct EpiResid {
    static constexpr bool PERM = true, AFTER_DRAIN = false; bf16_t* XB; float s; float* SSo;
    __device__ __forceinline__ void operator()(const f32x4 (&acc)[2][2][4][2], const pg8::Unit& u, int wr, int wc, int fr, int fq) const {
        const int row0 = u.pm * 256 + wr * 64 + fr, col0 = u.pn * 256 + wc * 32 + 8 * fq;
        u32x4 xin[2][4][2];
#pragma unroll
        for (int ai = 0; ai < 2; ++ai)
#pragma unroll
            for (int m = 0; m < 4; ++m)
#pragma unroll
                for (int bj = 0; bj < 2; ++bj) xin[ai][m][bj] = *(const u32x4*)(XB + (size_t)(row0 + ai * 128 + m * 16) * D + col0 + bj * 128);
#pragma unroll
        for (int ai = 0; ai < 2; ++ai)
#pragma unroll
            for (int m = 0; m < 4; ++m) { const size_t ro = (size_t)(row0 + ai * 128 + m * 16) * D + col0; float sq = 0.f;
#pragma unroll
                for (int bj = 0; bj < 2; ++bj) { const u32x4 xb = xin[ai][m][bj];
                    const f32x4 x0 = (f32x4){bf_lo(xb.x), bf_hi(xb.x), bf_lo(xb.y), bf_hi(xb.y)} + acc[ai][bj][m][0] * s, x1 = (f32x4){bf_lo(xb.z), bf_hi(xb.z), bf_lo(xb.w), bf_hi(xb.w)} + acc[ai][bj][m][1] * s;
                    sq += (x0[0] * x0[0] + x0[1] * x0[1]) + (x0[2] * x0[2] + x0[3] * x0[3]) + (x1[0] * x1[0] + x1[1] * x1[1]) + (x1[2] * x1[2] + x1[3] * x1[3]);
                    u32x4 w; w.x = cvt_pk_bf16(x0[0], x0[1]); w.y = cvt_pk_bf16(x0[2], x0[3]); w.z = cvt_pk_bf16(x1[0], x1[1]); w.w = cvt_pk_bf16(x1[2], x1[3]);
                    *(u32x4*)(XB + ro + bj * 128) = w; }
                sq += __shfl_xor(sq, 16); sq += __shfl_xor(sq, 32);
                if (fq == 0) SSo[(size_t)(u.pn * 4 + wc) * T + row0 + ai * 128 + m * 16] = sq; }
    }
};
struct EpiWin {
    static constexpr bool PERM = true, AFTER_DRAIN = false; bf16_t* VC; bf16_t* US; RTab rt_;
    __device__ __forceinline__ void operator()(const f32x4 (&acc)[2][2][4][2], const pg8::Unit& u, int wr, int wc, int fr, int fq) const {
        const int row0 = u.pm * 256 + wr * 64 + fr; const LAS float* rt = rt_.of(u.pm) + wr * 64 + fr;
        if (u.pn < 4) { const int col0 = u.pn * 128 + wc * 32 + 8 * fq;
#pragma unroll
            for (int ai = 0; ai < 2; ++ai)
#pragma unroll
                for (int m = 0; m < 4; ++m) { bf16_t* rowp = VC + (size_t)(row0 + ai * 128 + m * 16) * CONVC + col0; const float r = rt[ai * 128 + m * 16];
                    const f32x4 a0 = acc[ai][0][m][0] * r, a1 = acc[ai][0][m][1] * r, g0 = acc[ai][1][m][0] * r, g1 = acc[ai][1][m][1] * r;
                    u32x4 w; w.x = cvt_pk_bf16(a0[0] * fast_sigmoid(g0[0]), a0[1] * fast_sigmoid(g0[1])); w.y = cvt_pk_bf16(a0[2] * fast_sigmoid(g0[2]), a0[3] * fast_sigmoid(g0[3]));
                    w.z = cvt_pk_bf16(a1[0] * fast_sigmoid(g1[0]), a1[1] * fast_sigmoid(g1[1])); w.w = cvt_pk_bf16(a1[2] * fast_sigmoid(g1[2]), a1[3] * fast_sigmoid(g1[3]));
                    *(u32x4*)rowp = w; }
        } else { const int col0 = (u.pn - 4) * 256 + wc * 32 + 8 * fq;
#pragma unroll
            for (int ai = 0; ai < 2; ++ai)
#pragma unroll
                for (int m = 0; m < 4; ++m) { bf16_t* rowp = US + (size_t)(row0 + ai * 128 + m * 16) * SSMW + col0; const float r = rt[ai * 128 + m * 16];
#pragma unroll
                    for (int bj = 0; bj < 2; ++bj) { const f32x4 v0 = acc[ai][bj][m][0] * r, v1 = acc[ai][bj][m][1] * r;
                        u32x4 w; w.x = cvt_pk_bf16(v0[0], v0[1]); w.y = cvt_pk_bf16(v0[2], v0[3]); w.z = cvt_pk_bf16(v1[0], v1[1]); w.w = cvt_pk_bf16(v1[2], v1[3]);
                        *(u32x4*)(rowp + bj * 128) = w; } }
        }
    }
};
struct EpiBf {
    static constexpr bool PERM = true, AFTER_DRAIN = false; bf16_t* O; int ldc; int nscaled; float sc; RTab rt_; float* KMs;
    __device__ __forceinline__ void operator()(const f32x4 (&acc)[2][2][4][2], const pg8::Unit& u, int wr, int wc, int fr, int fq) const {
        const int row0 = u.pm * 256 + wr * 64 + fr, col0 = u.pn * 256 + wc * 32 + 8 * fq; const float s = (u.pn < nscaled) ? sc : 1.f; const LAS float* rt = rt_.of(u.pm) + wr * 64 + fr;
        f32x4 cs[2][2];
#pragma unroll
        for (int bj = 0; bj < 2; ++bj)
#pragma unroll
            for (int n = 0; n < 2; ++n) cs[bj][n] = (f32x4){0.f, 0.f, 0.f, 0.f};
#pragma unroll
        for (int ai = 0; ai < 2; ++ai)
#pragma unroll
            for (int m = 0; m < 4; ++m) { bf16_t* rowp = O + (size_t)(row0 + ai * 128 + m * 16) * ldc + col0; const float r = s * rt[ai * 128 + m * 16];
#pragma unroll
                for (int bj = 0; bj < 2; ++bj) { const f32x4 v0 = acc[ai][bj][m][0] * r, v1 = acc[ai][bj][m][1] * r; cs[bj][0] += v0; cs[bj][1] += v1;
                    u32x4 w; w.x = cvt_pk_bf16(v0[0], v0[1]); w.y = cvt_pk_bf16(v0[2], v0[3]); w.z = cvt_pk_bf16(v1[0], v1[1]); w.w = cvt_pk_bf16(v1[2], v1[3]);
                    *(u32x4*)(rowp + bj * 128) = w; } }
        if (KMs && u.pn >= 4) {
#pragma unroll
            for (int bj = 0; bj < 2; ++bj)
#pragma unroll
                for (int n = 0; n < 2; ++n)
#pragma unroll
                    for (int e = 0; e < 4; ++e) { float t = cs[bj][n][e]; t += __shfl_xor(t, 1); t += __shfl_xor(t, 2); t += __shfl_xor(t, 4); t += __shfl_xor(t, 8);
                        if (fr == 0) { const int c = col0 + bj * 128 + 4 * n + e - 1024; unsafeAtomicAdd(KMs + ((size_t)((u.pm >> 3) * NH + (c >> 7)) * 8 + (u.pm & 7)) * HD + (c & 127), t); } }
        }
    }
};
struct EpiVT {
    static constexpr bool PERM = true, AFTER_DRAIN = false; bf16_t* O; RTab rt_;
    __device__ __forceinline__ void operator()(const f32x4 (&acc)[2][2][4][2], const pg8::Unit& u, int wr, int wc, int fr, int fq) const {
        const int row0 = u.pm * 256 + wr * 64 + fr, col0 = u.pn * 256 + wc * 32 + 8 * fq;
        f32x4 rv[2][2]; const LAS float* rt = rt_.of(u.pn) + wc * 32 + 8 * fq;
#pragma unroll
        for (int bj = 0; bj < 2; ++bj)
#pragma unroll
            for (int n = 0; n < 2; ++n) rv[bj][n] = *(const LAS f32x4*)(rt + bj * 128 + 4 * n);
#pragma unroll
        for (int ai = 0; ai < 2; ++ai)
#pragma unroll
            for (int m = 0; m < 4; ++m) { const int dg = row0 + ai * 128 + m * 16, hh = dg >> 7, d = dg & 127;
#pragma unroll
                for (int bj = 0; bj < 2; ++bj) { const int tok = col0 + bj * 128, bb = tok >> 11, tl = tok & 2047;
                    const f32x4 v0 = acc[ai][bj][m][0] * rv[bj][0], v1 = acc[ai][bj][m][1] * rv[bj][1];
                    u32x4 w; w.x = cvt_pk_bf16(v0[0], v0[1]); w.y = cvt_pk_bf16(v0[2], v0[3]); w.z = cvt_pk_bf16(v1[0], v1[1]); w.w = cvt_pk_bf16(v1[2], v1[3]);
                    *(u32x4*)(O + ((((size_t)(bb * 8 + hh) * 32 + (tl >> 6)) * 128 + d) * 64 + (tl & 63))) = w; } }
    }
};
struct EpiGlu {
    static constexpr bool PERM = true, AFTER_DRAIN = false; const bf16_t* YB; const float* bias; bf16_t* CAT;
    __device__ __forceinline__ void operator()(const f32x4 (&acc)[2][2][4][2], const pg8::Unit& u, int wr, int wc, int fr, int fq) const {
        const int row0 = u.pm * 256 + wr * 64 + fr, col0 = u.pn * 256 + wc * 32 + 8 * fq;
#pragma unroll
        for (int bj = 0; bj < 2; ++bj) { const int c = col0 + bj * 128; const f32x4 b0 = *(const f32x4*)(bias + c), b1 = *(const f32x4*)(bias + c + 4);
#pragma unroll
            for (int ai = 0; ai < 2; ++ai)
#pragma unroll
                for (int m = 0; m < 4; ++m) { const size_t r = (size_t)(row0 + ai * 128 + m * 16);
                    const u32x4 y = *(const u32x4*)(YB + r * SSMW + c); const f32x4 v0 = acc[ai][bj][m][0] + b0, v1 = acc[ai][bj][m][1] + b1;
                    u32x4 w; w.x = cvt_pk_bf16(bf_lo(y.x) * fast_sigmoid(v0[0]), bf_hi(y.x) * fast_sigmoid(v0[1])); w.y = cvt_pk_bf16(bf_lo(y.y) * fast_sigmoid(v0[2]), bf_hi(y.y) * fast_sigmoid(v0[3]));
                    w.z = cvt_pk_bf16(bf_lo(y.z) * fast_sigmoid(v1[0]), bf_hi(y.z) * fast_sigmoid(v1[1])); w.w = cvt_pk_bf16(bf_lo(y.w) * fast_sigmoid(v1[2]), bf_hi(y.w) * fast_sigmoid(v1[3]));
                    *(u32x4*)(CAT + r * D + 512 + c) = w; } }
    }
};

struct TrDesc { const float* W; const float* gain; bf16_t* WT; int ldw, K, drow0, k0, n0; };
__device__ __forceinline__ TrDesc tr_desc(const float* W, int ldw, int K, bf16_t* WT, int nblk, int mode, int arg, const float* gain, int item) {
    TrDesc d; const int kb = item / nblk, nb = item % nblk; d.k0 = 64 * kb; d.n0 = 32 * nb; d.W = W; d.gain = gain; d.WT = WT; d.ldw = ldw; d.K = K;
    d.drow0 = mode == 0 ? arg + d.n0 : (d.n0 >> 7) * 256 + arg * 128 + (d.n0 & 127); return d;
}
__device__ __forceinline__ void tr_load(const TrDesc& d, float (&v)[32], int lane) {
#pragma unroll
    for (int i = 0; i < 32; ++i) { const int kk = 2 * i + (lane >> 5); v[i] = d.W[(size_t)(d.k0 + kk) * d.ldw + d.n0 + (lane & 31)]; }
}
__device__ __forceinline__ void tr_store(const TrDesc& d, float (&v)[32], LAS float* scr, int lane) {
    if (d.gain) {
#pragma unroll
        for (int i = 0; i < 32; ++i) v[i] *= d.gain[d.k0 + 2 * i + (lane >> 5)]; }
#pragma unroll
    for (int i = 0; i < 32; ++i) { const int kk = 2 * i + (lane >> 5); scr[kk * 33 + (lane & 31)] = v[i]; }
    asm volatile("s_waitcnt lgkmcnt(0)" ::: "memory");
    const int c = lane & 7;
#pragma unroll
    for (int j = 0; j < 4; ++j) { const int n = (lane >> 3) + 8 * j; const LAS float* s = scr + (8 * c) * 33 + n;
        u32x4 o; o.x = cvt_pk_bf16(s[0 * 33], s[1 * 33]); o.y = cvt_pk_bf16(s[2 * 33], s[3 * 33]); o.z = cvt_pk_bf16(s[4 * 33], s[5 * 33]); o.w = cvt_pk_bf16(s[6 * 33], s[7 * 33]);
        *(u32x4*)(d.WT + (size_t)(d.drow0 + n) * d.K + d.k0 + 8 * c) = o; }
    asm volatile("s_waitcnt lgkmcnt(0)" ::: "memory");
}

__device__ __forceinline__ void xb_rows(const float* X, bf16_t* XB, float* SS0, int gw, int NGW, int lane) {
    for (int m0 = 4 * gw; m0 < T; m0 += 4 * NGW) { f32x4 v[4][4];
#pragma unroll
        for (int q = 0; q < 4; ++q)
#pragma unroll
            for (int j = 0; j < 4; ++j) v[q][j] = ((const f32x4*)(X + (size_t)(m0 + q) * D) + lane)[64 * j];
#pragma unroll
        for (int q = 0; q < 4; ++q) { float s = 0.f;
#pragma unroll
            for (int j = 0; j < 4; ++j) s += (v[q][j].x * v[q][j].x + v[q][j].y * v[q][j].y) + (v[q][j].z * v[q][j].z + v[q][j].w * v[q][j].w);
            s = wave_sum(s); if (lane < 16) SS0[(size_t)lane * T + m0 + q] = (lane == 0) ? s : 0.f;
            u32x2* o = (u32x2*)(XB + (size_t)(m0 + q) * D) + lane;
#pragma unroll
            for (int j = 0; j < 4; ++j) { u32x2 w; w.x = cvt_pk_bf16(v[q][j].x, v[q][j].y); w.y = cvt_pk_bf16(v[q][j].z, v[q][j].w); o[64 * j] = w; } } }
}
__device__ __forceinline__ void final_rows(const bf16_t* XB, float* out, const float* g, const float* SS, int gw, int NGW, int lane) {
    f32x4 gv[4];
#pragma unroll
    for (int j = 0; j < 4; ++j) gv[j] = ((const f32x4*)g)[lane + 64 * j];
    for (int m0 = 4 * gw; m0 < T; m0 += 4 * NGW) {
        u32x2 w[4][4]; float tp[4];
#pragma unroll
        for (int q = 0; q < 4; ++q) { const u32x2* xr = (const u32x2*)(XB + (size_t)(m0 + q) * D) + lane;
#pragma unroll
            for (int j = 0; j < 4; ++j) w[q][j] = xr[64 * j];
            tp[q] = (lane < 16) ? SS[(size_t)lane * T + m0 + q] : 0.f; }
#pragma unroll
        for (int q = 0; q < 4; ++q) { float t = tp[q]; t += __shfl_xor(t, 1); t += __shfl_xor(t, 2); t += __shfl_xor(t, 4); t += __shfl_xor(t, 8); const float r = rs_of(__shfl(t, 0));
            f32x4* o = (f32x4*)(out + (size_t)(m0 + q) * D) + lane;
#pragma unroll
            for (int j = 0; j < 4; ++j) o[64 * j] = (f32x4){bf_lo(w[q][j].x), bf_hi(w[q][j].x), bf_lo(w[q][j].y), bf_hi(w[q][j].y)} * r * gv[j]; } }
}

__device__ __forceinline__ void conv_phase(LAS unsigned char* lds, const bf16_t* VC, const float* cw, const float* cb, const float* lng, const float* lnb, bf16_t* CAT, int tid, int lane, int wave) {
    const int cp = tid & 255, th = tid >> 8;
    f32x2v wk[TAPS];
#pragma unroll
    for (int k = 0; k < TAPS; ++k) wk[k] = *(const f32x2v*)(cw + k * CONVC + 2 * cp);
    const f32x2v bias = *(const f32x2v*)(cb + 2 * cp);
    LAS float* ybuf = (LAS float*)lds;
    unsigned vn[38];
#define CONV_LOAD(dst, it_) do { const int t0_ = (it_) * 16 + th * 8, tb_ = t0_ & (SEQ - 1); \
        _Pragma("unroll") for (int r = 0; r < 38; ++r) { const int pos = tb_ - 30 + r; dst[r] = *(const unsigned*)(VC + (size_t)(t0_ - tb_ + (pos < 0 ? 0 : pos)) * CONVC + 2 * cp); } } while (0)
    if ((int)blockIdx.x < T / 16) CONV_LOAD(vn, (int)blockIdx.x);
    for (int it = blockIdx.x; it < T / 16; it += gridDim.x) {
        const int t0 = it * 16 + th * 8, tb = t0 & (SEQ - 1);
        f32x2v av[8];
#pragma unroll
        for (int t = 0; t < 8; ++t) av[t] = bias;
        unsigned vv[38];
#pragma unroll
        for (int r = 0; r < 38; ++r) vv[r] = vn[r];
        if (it + (int)gridDim.x < T / 16) CONV_LOAD(vn, it + (int)gridDim.x);
#pragma unroll
        for (int r = 0; r < 38; ++r) {
            const unsigned v = (tb - 30 + r >= 0) ? vv[r] : 0u;
            const f32x2v vf = {bf_lo(v), bf_hi(v)};
#pragma unroll
            for (int t = 0; t < 8; ++t) { const int k = r - t; if (k >= 0 && k < TAPS) av[t] = __builtin_elementwise_fma(wk[k], vf, av[t]); }
        }
#pragma unroll
        for (int t = 0; t < 8; ++t) *(LAS f32x2v*)(ybuf + (th * 8 + t) * CONVC + 2 * cp) = av[t];
        __syncthreads();
        {   f32x4 y0[2], y1[2]; float sm[2], sq[2];
#pragma unroll
            for (int q = 0; q < 2; ++q) { const LAS float* yr = ybuf + (wave * 2 + q) * CONVC + lane * 8; y0[q] = *(const LAS f32x4*)yr; y1[q] = *(const LAS f32x4*)(yr + 4);
                sm[q] = (y0[q].x + y0[q].y) + (y0[q].z + y0[q].w) + (y1[q].x + y1[q].y) + (y1[q].z + y1[q].w);
                sq[q] = (y0[q].x * y0[q].x + y0[q].y * y0[q].y) + (y0[q].z * y0[q].z + y0[q].w * y0[q].w) + (y1[q].x * y1[q].x + y1[q].y * y1[q].y) + (y1[q].z * y1[q].z + y1[q].w * y1[q].w); }
#pragma unroll
            for (int o = 1; o < 64; o <<= 1) { const float a0 = __shfl_xor(sm[0], o), a1 = __shfl_xor(sq[0], o), a2 = __shfl_xor(sm[1], o), a3 = __shfl_xor(sq[1], o); sm[0] += a0; sq[0] += a1; sm[1] += a2; sq[1] += a3; }
            const f32x4 g0 = *(const f32x4*)(lng + lane * 8), g1 = *(const f32x4*)(lng + lane * 8 + 4), b0 = *(const f32x4*)(lnb + lane * 8), b1 = *(const f32x4*)(lnb + lane * 8 + 4);
#pragma unroll
            for (int q = 0; q < 2; ++q) { const float mu = sm[q] * (1.f / CONVC); const float var = fmaxf(sq[q] * (1.f / CONVC) - mu * mu, 0.f);
                const float rs = 1.0f / sqrtf(var + 1e-5f);
                const f32x4 z0 = (y0[q] - mu) * rs * g0 + b0, z1 = (y1[q] - mu) * rs * g1 + b1;
                u32x4 w; w.x = cvt_pk_bf16(fast_silu(z0.x), fast_silu(z0.y)); w.y = cvt_pk_bf16(fast_silu(z0.z), fast_silu(z0.w)); w.z = cvt_pk_bf16(fast_silu(z1.x), fast_silu(z1.y)); w.w = cvt_pk_bf16(fast_silu(z1.z), fast_silu(z1.w));
                *(u32x4*)(CAT + (size_t)(it * 16 + wave * 2 + q) * D + lane * 8) = w; } }
        __syncthreads();
    }
}

constexpr size_t WS_ABAR = 1 * MiB, WS_BBH = 1 * MiB + 65536, WS_BBL = 1 * MiB + 262144;
constexpr size_t WS_CMH = 1 * MiB + 393216, WS_CML = 1 * MiB + 589824;
constexpr int TSTR = 132;
__device__ __forceinline__ void ssm_tables(int idx, const float* a_re, const float* a_im, const float* b_re, const float* b_im, const float* log_dt, float* ABAR, bf16_t* BBH, bf16_t* BBL) {
    const int g = idx >> 6, p = idx & 63;
    const float dt = expf(log_dt[g]), are = a_re[idx], aim = a_im[idx];
    const float mag = expf(dt * are), ang = dt * aim, ar = mag * cosf(ang), ai = mag * sinf(ang);
    ABAR[2 * idx] = ar; ABAR[2 * idx + 1] = ai;
    const float den = are * are + aim * aim, nr = ar - 1.f, ni = ai;
    const float qr = (nr * are + ni * aim) / den, qi = (ni * are - nr * aim) / den;
    const float* pbr = b_re + (size_t)idx * 16; const float* pbi = b_im + (size_t)idx * 16;
#pragma unroll
    for (int h8 = 0; h8 < 2; ++h8) { float vr[8], vi[8];
#pragma unroll
        for (int e = 0; e < 8; ++e) { const float r = pbr[8 * h8 + e], i = pbi[8 * h8 + e]; vr[e] = qr * r - qi * i; vi[e] = qr * i + qi * r; }
        u32x4 hr, lr, hi, li;
#pragma unroll
        for (int e = 0; e < 4; ++e) { const unsigned a = cvt_pk_bf16(vr[2 * e], vr[2 * e + 1]); hr[e] = a; lr[e] = cvt_pk_bf16(vr[2 * e] - bf_lo(a), vr[2 * e + 1] - bf_hi(a));
            const unsigned c = cvt_pk_bf16(vi[2 * e], vi[2 * e + 1]); hi[e] = c; li[e] = cvt_pk_bf16(vi[2 * e] - bf_lo(c), vi[2 * e + 1] - bf_hi(c)); }
        *(u32x4*)(BBH + ((size_t)(g * 128 + p) * 16 + 8 * h8)) = hr; *(u32x4*)(BBL + ((size_t)(g * 128 + p) * 16 + 8 * h8)) = lr;
        *(u32x4*)(BBH + ((size_t)(g * 128 + 64 + p) * 16 + 8 * h8)) = hi; *(u32x4*)(BBL + ((size_t)(g * 128 + 64 + p) * 16 + 8 * h8)) = li; }
}
__device__ __forceinline__ void ssm_ctable(int idx, const float* c_re, const float* c_im, bf16_t* CMH, bf16_t* CML) {
    const int gh = idx >> 4, c8 = idx & 15; const float* src = (c8 < 8 ? c_re : c_im) + (size_t)gh * NS + (c8 & 7) * 8; const float sg = c8 < 8 ? 1.f : -1.f;
    const f32x4 a = *(const f32x4*)src * sg, b = *(const f32x4*)(src + 4) * sg;
    u32x4 h, l;
    h.x = cvt_pk_bf16(a[0], a[1]); h.y = cvt_pk_bf16(a[2], a[3]); h.z = cvt_pk_bf16(b[0], b[1]); h.w = cvt_pk_bf16(b[2], b[3]);
    l.x = cvt_pk_bf16(a[0] - bf_lo(h.x), a[1] - bf_hi(h.x)); l.y = cvt_pk_bf16(a[2] - bf_lo(h.y), a[3] - bf_hi(h.y)); l.z = cvt_pk_bf16(b[0] - bf_lo(h.z), b[1] - bf_hi(h.z)); l.w = cvt_pk_bf16(b[2] - bf_lo(h.w), b[3] - bf_hi(h.w));
    *(u32x4*)(CMH + (size_t)gh * 128 + c8 * 8) = h; *(u32x4*)(CML + (size_t)gh * 128 + c8 * 8) = l;
}
struct SsmOps { bf16x8 bh[8]; float ar, ai; };
__device__ __forceinline__ void ssm_ops_load(SsmOps& S, const float* ABAR, const bf16_t* BBH, const bf16_t* BBL, int g, int lane) {
    const int fr = lane & 15, fq = lane >> 4; const bf16x8 z = {0, 0, 0, 0, 0, 0, 0, 0};
#pragma unroll
    for (int nb = 0; nb < 8; ++nb) { const size_t o = (size_t)(g * 128 + 16 * nb + fr) * 16 + (fq & 1) * 8;
        const bf16x8 h = *(const bf16x8*)(BBH + o); S.bh[nb] = fq < 2 ? h : z; }
    S.ar = ABAR[2 * (g * 64 + lane)]; S.ai = ABAR[2 * (g * 64 + lane) + 1];
}
__device__ __forceinline__ void ssm_u_load(bf16x8& uh, const bf16_t* US, int tok, int g, int lane) {
    uh = *(const bf16x8*)(US + (size_t)(tok + (lane & 15)) * SSMW + g * 16 + ((lane >> 4) & 1) * 8);
}
__device__ __forceinline__ void ssm_bu_tile(const SsmOps& S, bf16x8 uh, LAS float* tile, int lane) {
    const int fr = lane & 15, fq = lane >> 4;
    if (fq >= 2) uh = (bf16x8){0, 0, 0, 0, 0, 0, 0, 0};
#pragma unroll
    for (int nb = 0; nb < 8; ++nb) { f32x4 acc = {0.f, 0.f, 0.f, 0.f};
        acc = __builtin_amdgcn_mfma_f32_16x16x32_bf16(S.bh[nb], uh, acc, 0, 0, 0);
        *(LAS f32x4*)(tile + fr * TSTR + 16 * nb + 4 * fq) = acc; }
    asm volatile("s_waitcnt lgkmcnt(0)" ::: "memory");
}
__device__ __forceinline__ void ssm_pass1(LAS unsigned char* lds, const bf16_t* US, float* SST, const float* ABAR, const bf16_t* BBH, const bf16_t* BBL, int gw, int NGW, int lane, int wave) {
    LAS float* tile = (LAS float*)(lds + 32768 + wave * (16 * TSTR * 4));
    for (int idx = gw; idx < NB * NG * 7; idx += NGW) {
        const int c = idx % 7, bg = idx / 7, b = bg >> 5, g = bg & 31;
        SsmOps S; ssm_ops_load(S, ABAR, BBH, BBL, g, lane);
        float xr = 0.f, xi = 0.f; const int tokc = b * SEQ + c * 256;
        bf16x8 uh; ssm_u_load(uh, US, tokc, g, lane);
        for (int grp = 0; grp < 16; ++grp) {
            ssm_bu_tile(S, uh, tile, lane);
            if (grp < 15) ssm_u_load(uh, US, tokc + (grp + 1) * 16, g, lane);
            float br[16], bi[16];
#pragma unroll
            for (int t = 0; t < 16; ++t) { br[t] = tile[t * TSTR + lane]; bi[t] = tile[t * TSTR + 64 + lane]; }
            asm volatile("s_waitcnt lgkmcnt(0)" ::: "memory");
#pragma unroll
            for (int t = 0; t < 16; ++t) { const float nr = S.ar * xr - S.ai * xi + br[t], ni = S.ar * xi + S.ai * xr + bi[t]; xr = nr; xi = ni; }
        }
        float* so = SST + ((size_t)bg * 8 + c) * 128; so[lane] = xr; so[64 + lane] = xi;
    }
}
__device__ __forceinline__ void ssm_pass2(LAS unsigned char* lds, const bf16_t* US, const float* SST, bf16_t* YB, const float* ABAR, const bf16_t* BBH, const bf16_t* BBL, const bf16_t* CMH, const bf16_t* CML, const float* dco, int gw, int NGW, int lane, int wave) {
    LAS float* tile = (LAS float*)(lds + wave * (16 * TSTR * 4));
    const int fr = lane & 15, fq = lane >> 4;
    for (int idx = gw; idx < NB * NG * 8; idx += NGW) {
        const int c = idx & 7, bg = idx >> 3, b = bg >> 5, g = bg & 31;
        SsmOps S; ssm_ops_load(S, ABAR, BBH, BBL, g, lane);
        bf16x8 ch[4];
#pragma unroll
        for (int ks = 0; ks < 4; ++ks) { const size_t o = (size_t)(g * 16 + fr) * 128 + ks * 32 + fq * 8; ch[ks] = *(const bf16x8*)(CMH + o); }
        const float dh = dco[g * 16 + fr];
        float pr = S.ar, pi = S.ai;
#pragma unroll
        for (int s = 0; s < 8; ++s) { const float nr = pr * pr - pi * pi, ni = 2.f * pr * pi; pr = nr; pi = ni; }
        float xr = 0.f, xi = 0.f;
        { float sr[7], sm[7];
#pragma unroll
          for (int cc = 0; cc < 7; ++cc) { const float* si = SST + ((size_t)bg * 8 + (cc < c ? cc : 0)) * 128; sr[cc] = si[lane]; sm[cc] = si[64 + lane]; }
#pragma unroll
          for (int cc = 0; cc < 7; ++cc) if (cc < c) { const float nr = pr * xr - pi * xi + sr[cc], ni = pr * xi + pi * xr + sm[cc]; xr = nr; xi = ni; } }
        const int tokc = b * SEQ + c * 256;
        bf16x8 uh; ssm_u_load(uh, US, tokc, g, lane);
        for (int grp = 0; grp < 16; ++grp) { const int tok = tokc + grp * 16;
            ssm_bu_tile(S, uh, tile, lane);
            if (grp < 15) ssm_u_load(uh, US, tok + 16, g, lane);
            float ud[4];
#pragma unroll
            for (int i = 0; i < 4; ++i) ud[i] = bf_lo((unsigned)US[(size_t)(tok + 4 * fq + i) * SSMW + g * 16 + fr]);
            float br[16], bi[16];
#pragma unroll
            for (int t = 0; t < 16; ++t) { br[t] = tile[t * TSTR + lane]; bi[t] = tile[t * TSTR + 64 + lane]; }
            asm volatile("s_waitcnt lgkmcnt(0)" ::: "memory");
#pragma unroll
            for (int t = 0; t < 16; ++t) { const float nr = S.ar * xr - S.ai * xi + br[t], ni = S.ar * xi + S.ai * xr + bi[t]; xr = nr; xi = ni; br[t] = xr; bi[t] = xi; }
#pragma unroll
            for (int t = 0; t < 16; ++t) { tile[t * TSTR + lane] = br[t]; tile[t * TSTR + 64 + lane] = bi[t]; }
            asm volatile("s_waitcnt lgkmcnt(0)" ::: "memory");
            f32x4 acc = {0.f, 0.f, 0.f, 0.f}, acc2 = {0.f, 0.f, 0.f, 0.f};
            f32x4 xa[4][2];
#pragma unroll
            for (int ks = 0; ks < 4; ++ks) { xa[ks][0] = *(const LAS f32x4*)(tile + fr * TSTR + ks * 32 + fq * 8); xa[ks][1] = *(const LAS f32x4*)(tile + fr * TSTR + ks * 32 + fq * 8 + 4); }
#pragma unroll
            for (int ks = 0; ks < 4; ++ks) { const f32x4 x0 = xa[ks][0], x1 = xa[ks][1]; u32x4 h;
                h.x = cvt_pk_bf16(x0[0], x0[1]); h.y = cvt_pk_bf16(x0[2], x0[3]); h.z = cvt_pk_bf16(x1[0], x1[1]); h.w = cvt_pk_bf16(x1[2], x1[3]);
                const bf16x8 xh = __builtin_bit_cast(bf16x8, h);
                if (ks & 1) acc2 = __builtin_amdgcn_mfma_f32_16x16x32_bf16(xh, ch[ks], acc2, 0, 0, 0); else acc = __builtin_amdgcn_mfma_f32_16x16x32_bf16(xh, ch[ks], acc, 0, 0, 0); }
            acc = acc + acc2;
#pragma unroll
            for (int i = 0; i < 4; ++i) { const float y = acc[i] + dh * ud[i];
                const unsigned w = cvt_pk_bf16(gelu_tanh(y), 0.f); YB[(size_t)(tok + 4 * fq + i) * SSMW + g * 16 + fr] = (bf16_t)(w & 0xffffu); }
            asm volatile("s_waitcnt lgkmcnt(0)" ::: "memory");
        }
    }
}

__device__ __forceinline__ void kmean_phase(LAS unsigned char* lds, const bf16_t* QK, float* KM, int tid) {
    const int cp = tid & 255, rh = tid >> 8; LAS float* red = (LAS float*)lds;
    for (int it = blockIdx.x; it < 256; it += gridDim.x) { const int b = it >> 4, n = (it >> 1) & 7, ch = it & 1;
        const bf16_t* p = QK + (size_t)(b * SEQ + n * 256 + rh * 128) * 2048 + 1024 + ch * 512 + 2 * cp; float s0 = 0.f, s1 = 0.f;
#pragma unroll 8
        for (int r = 0; r < 128; ++r) { const unsigned v = *(const unsigned*)(p + (size_t)r * 2048); s0 += bf_lo(v); s1 += bf_hi(v); }
        if (rh == 1) { red[2 * cp] = s0; red[2 * cp + 1] = s1; }
        __syncthreads();
        if (rh == 0) { s0 += red[2 * cp]; s1 += red[2 * cp + 1]; const int col = ch * 512 + 2 * cp, hh = col >> 7, d = col & 127;
            f32x2v o; o.x = s0 * (1.f / 256.f); o.y = s1 * (1.f / 256.f); *(f32x2v*)(KM + ((size_t)(b * NH + hh) * 8 + n) * HD + d) = o; }
        __syncthreads();
    }
}

__device__ __forceinline__ float max3f(float a, float b, float c) { float r; asm("v_max3_f32 %0, %1, %2, %3" : "=v"(r) : "v"(a), "v"(b), "v"(c)); return r; }
constexpr int ATT_KROW = 272, ATT_VROW = 144, ATT_KB = 64 * ATT_KROW, ATT_VB = 128 * ATT_VROW, ATT_STAGE = ATT_KB + ATT_VB;
__device__ __forceinline__ void attn_unit(LAS unsigned char* lds, const bf16_t* QK, const bf16_t* VTt, const float* KM, bf16_t* OA, int b, int h, int qb, int tid, int lane, int wave) {
    const int r32 = lane & 31, hf = lane >> 5;
    const int row0 = b * SEQ + qb * 256 + wave * 32;
    const char* kg = (const char*)(QK + (size_t)(b * SEQ) * 2048 + 1024 + h * HD);
    const char* vg = (const char*)(VTt + (size_t)((b * NH + h) * 32) * 8192);
    unsigned goff[5];
#pragma unroll
    for (int j = 0; j < 5; ++j) { int p = wave + 8 * j; p = p > 34 ? 34 : p; const int off = p * 1024 + lane * 16;
        if (p < 17) { const int r = off / ATT_KROW, cb = off % ATT_KROW; goff[j] = (unsigned)(r * 4096 + (cb < 256 ? cb : 0)); }
        else { const int o2 = off - ATT_KB, d = o2 / ATT_VROW, cb = o2 % ATT_VROW; goff[j] = (unsigned)(d * 128 + (cb < 128 ? cb : 0)); } }
    const int ntiles = 4 * (qb + 1);
#define ATT_DMA(i_, st_) do { const int key0_ = (qb - ((i_) >> 2)) * 256 + ((i_) & 3) * 64; const char* kb_ = kg + (size_t)key0_ * 4096; const char* vb_ = vg + (size_t)(key0_ >> 6) * 16384; \
        _Pragma("unroll") for (int j_ = 0; j_ < 5; ++j_) { int p_ = wave + 8 * j_; p_ = p_ > 34 ? 34 : p_; \
            __builtin_amdgcn_global_load_lds((const unsigned*)((p_ < 17 ? kb_ : vb_) + goff[j_]), (LAS unsigned*)(lds + (st_) * ATT_STAGE + p_ * 1024), 16, 0, 0); } } while (0)
    ATT_DMA(0, 0); ATT_DMA(1, 1);
    bf16x8 qf[8];
    { const bf16_t* qp = QK + (size_t)(row0 + r32) * 2048 + h * HD + hf * 8;
#pragma unroll
      for (int ks = 0; ks < 8; ++ks) qf[ks] = *(const bf16x8*)(qp + ks * 16); }
    unsigned sel = (1u << qb) - 1u;
    if (qb > 3) {
        float gate[7];
#pragma unroll
        for (int n = 0; n < 7; ++n) { gate[n] = -INFINITY;
            if (n < qb) { const float* kp = KM + ((size_t)(b * NH + h) * 8 + n) * HD + hf * 8; float s = 0.f;
#pragma unroll
                for (int ks = 0; ks < 8; ++ks) { const f32x4 k0 = *(const f32x4*)(kp + ks * 16), k1 = *(const f32x4*)(kp + ks * 16 + 4); const u32x4 q = __builtin_bit_cast(u32x4, qf[ks]);
                    s += bf_lo(q.x) * k0.x + bf_hi(q.x) * k0.y + bf_lo(q.y) * k0.z + bf_hi(q.y) * k0.w + bf_lo(q.z) * k1.x + bf_hi(q.z) * k1.y + bf_lo(q.w) * k1.z + bf_hi(q.w) * k1.w; }
                gate[n] = s + __shfl_xor(s, 32); } }
        sel = 0u;
#pragma unroll
        for (int rnd = 0; rnd < 3; ++rnd) { float best = -INFINITY; int bi = 0;
#pragma unroll
            for (int n = 0; n < 7; ++n) { const bool ok = (n < qb) && !((sel >> n) & 1u) && (gate[n] > best); best = ok ? gate[n] : best; bi = ok ? n : bi; }
            sel |= 1u << bi; }
    }
    f32x16 o[4];
#pragma unroll
    for (int db = 0; db < 4; ++db)
#pragma unroll
        for (int i = 0; i < 16; ++i) o[db][i] = 0.f;
    float mrun = -1e30f, lrun = 0.f;
    const int pi_r = ((r32 >> 2) & 1) * 16 + (r32 >> 3) * 4 + (r32 & 3);
    const int qq = wave * 32 + r32;
    const unsigned kread = pi_r * ATT_KROW + hf * 16, vread = ATT_KB + r32 * ATT_VROW + hf * 32;
    asm volatile("s_waitcnt vmcnt(0)" ::: "memory"); __builtin_amdgcn_s_barrier(); asm volatile("" ::: "memory");
    int st = 0;
    for (int i = 0; i < ntiles; ++i) {
        const int kb = qb - (i >> 2), t = i & 3; const bool own = (kb == qb); const bool on = own || ((sel >> kb) & 1u);
        const bool active = own ? (64 * t <= wave * 32 + 31) : (__ballot(on) != 0ull);
        if (active) {
            const LAS unsigned char* sb = lds + st * ATT_STAGE;
            f32x16 s0, s1;
#pragma unroll
            for (int e = 0; e < 16; ++e) { s0[e] = 0.f; s1[e] = 0.f; }
            bf16x8 fa[8], fb[8];
#pragma unroll
            for (int ks = 0; ks < 8; ++ks) fa[ks] = *(const LAS bf16x8*)(sb + kread + ks * 32);
#pragma unroll
            for (int ks = 0; ks < 8; ++ks) fb[ks] = *(const LAS bf16x8*)(sb + kread + 32 * ATT_KROW + ks * 32);
            __builtin_amdgcn_sched_barrier(0);
#pragma unroll
            for (int ks = 0; ks < 8; ++ks) s0 = __builtin_amdgcn_mfma_f32_32x32x16_bf16(fa[ks], qf[ks], s0, 0, 0, 0);
            __builtin_amdgcn_sched_barrier(0);
#pragma unroll
            for (int db = 0; db < 4; ++db)
#pragma unroll
                for (int s2 = 0; s2 < 2; ++s2) fa[db * 2 + s2] = *(const LAS bf16x8*)(sb + vread + db * 32 * ATT_VROW + s2 * 16);
#pragma unroll
            for (int ks = 0; ks < 8; ++ks) s1 = __builtin_amdgcn_mfma_f32_32x32x16_bf16(fb[ks], qf[ks], s1, 0, 0, 0);
            __builtin_amdgcn_sched_barrier(0);
#pragma unroll
            for (int db = 0; db < 4; ++db)
#pragma unroll
                for (int s2 = 0; s2 < 2; ++s2) fb[db * 2 + s2] = *(const LAS bf16x8*)(sb + vread + db * 32 * ATT_VROW + 64 + s2 * 16);
            if (own && (64 * t + 63 > wave * 32)) {
                const int kk0 = t * 64 + hf * 16;
#pragma unroll
                for (int e = 0; e < 16; ++e) { s0[e] = (kk0 + e <= qq) ? s0[e] : -INFINITY; s1[e] = (kk0 + 32 + e <= qq) ? s1[e] : -INFINITY; }
            }
            float mxa = max3f(s0[0], s0[1], s1[0]), mxb = max3f(s0[2], s0[3], s1[1]); mxa = max3f(mxa, s1[2], s1[3]);
#pragma unroll
            for (int e = 4; e < 16; e += 4) { mxa = max3f(mxa, s0[e], s0[e + 1]); mxb = max3f(mxb, s0[e + 2], s0[e + 3]); mxa = max3f(mxa, s1[e], s1[e + 1]); mxb = max3f(mxb, s1[e + 2], s1[e + 3]); }
            float mx = on ? max3f(mxa, mxb, mxb) : -INFINITY;
            { const auto rr = __builtin_amdgcn_permlane32_swap(__builtin_bit_cast(unsigned, mx), __builtin_bit_cast(unsigned, mx), false, false);
              mx = fmaxf(__builtin_bit_cast(float, rr[0]), __builtin_bit_cast(float, rr[1])); }
            float alpha = 1.f;
            if (__ballot(mx > mrun + 8.f) != 0ull) { const float mnew = fmaxf(mrun, mx); alpha = __builtin_amdgcn_exp2f(mrun - mnew); mrun = mnew;
#pragma unroll
                for (int db = 0; db < 4; ++db)
#pragma unroll
                    for (int e = 0; e < 16; ++e) o[db][e] *= alpha; }
            const float msub = on ? mrun : INFINITY;
            float ps = 0.f;
#pragma unroll
            for (int e = 0; e < 16; ++e) { s0[e] = __builtin_amdgcn_exp2f(s0[e] - msub); s1[e] = __builtin_amdgcn_exp2f(s1[e] - msub); ps += s0[e] + s1[e]; }
            lrun = lrun * alpha + ps;
            bf16x8 pf[2][2];
#pragma unroll
            for (int s2 = 0; s2 < 2; ++s2) { u32x4 w; w.x = cvt_pk_bf16(s0[8 * s2 + 0], s0[8 * s2 + 1]); w.y = cvt_pk_bf16(s0[8 * s2 + 2], s0[8 * s2 + 3]); w.z = cvt_pk_bf16(s0[8 * s2 + 4], s0[8 * s2 + 5]); w.w = cvt_pk_bf16(s0[8 * s2 + 6], s0[8 * s2 + 7]); pf[0][s2] = __builtin_bit_cast(bf16x8, w);
                u32x4 v; v.x = cvt_pk_bf16(s1[8 * s2 + 0], s1[8 * s2 + 1]); v.y = cvt_pk_bf16(s1[8 * s2 + 2], s1[8 * s2 + 3]); v.z = cvt_pk_bf16(s1[8 * s2 + 4], s1[8 * s2 + 5]); v.w = cvt_pk_bf16(s1[8 * s2 + 6], s1[8 * s2 + 7]); pf[1][s2] = __builtin_bit_cast(bf16x8, v); }
            __builtin_amdgcn_sched_barrier(0);
#pragma unroll
            for (int s2 = 0; s2 < 2; ++s2)
#pragma unroll
                for (int db = 0; db < 4; ++db) o[db] = __builtin_amdgcn_mfma_f32_32x32x16_bf16(fa[db * 2 + s2], pf[0][s2], o[db], 0, 0, 0);
#pragma unroll
            for (int s2 = 0; s2 < 2; ++s2)
#pragma unroll
                for (int db = 0; db < 4; ++db) o[db] = __builtin_amdgcn_mfma_f32_32x32x16_bf16(fb[db * 2 + s2], pf[1][s2], o[db], 0, 0, 0);
        }
        if (!(i & 1) && i + 2 < ntiles) { ATT_DMA(i + 2, (st + 2) & 3); ATT_DMA(i + 3, (st + 3) & 3); }
        if (i & 1) { asm volatile("s_waitcnt vmcnt(0)" ::: "memory");
            asm volatile("s_waitcnt lgkmcnt(0)" ::: "memory"); __builtin_amdgcn_s_barrier(); asm volatile("" ::: "memory"); }
        st = (st + 1) & 3;
    }
#undef ATT_DMA
    const float inv = 1.f / (lrun + __shfl_xor(lrun, 32));
    bf16_t* op = OA + (size_t)(row0 + r32) * D + h * HD + hf * 4;
#pragma unroll
    for (int db = 0; db < 4; ++db)
#pragma unroll
        for (int rg = 0; rg < 4; ++rg) { u32x2 w; w.x = cvt_pk_bf16(o[db][4 * rg] * inv, o[db][4 * rg + 1] * inv); w.y = cvt_pk_bf16(o[db][4 * rg + 2] * inv, o[db][4 * rg + 3] * inv);
            *(u32x2*)(op + db * 32 + rg * 8) = w; }
}

#define XB_TMO      128
#define XB_XCNT(j)  (256  + 64 * (j))
#define XB_XSUB(j)  (1280 + 64 * (j))
#define XB_XGEN(j)  (2304 + 64 * (j))
#define XB_TOP      3328
#define XB_TOPGEN   3392
#define XCD_BAR_WORDS 3456
#define XB_SPIN_CAP (1u << 18)

__device__ __forceinline__ unsigned xb_ld(unsigned* p)              { return __hip_atomic_load(p, __ATOMIC_RELAXED, __HIP_MEMORY_SCOPE_AGENT); }
__device__ __forceinline__ unsigned xb_add(unsigned* p, unsigned v) { return __hip_atomic_fetch_add(p, v, __ATOMIC_RELAXED, __HIP_MEMORY_SCOPE_AGENT); }
__device__ __forceinline__ unsigned xb_xcc_id() { return (unsigned)__builtin_amdgcn_s_getreg((3 << 11) | 20) & 0xFu; }
#define XB_SPIN(cond, bar) do { unsigned _sp = 0; while (cond) { __builtin_amdgcn_s_sleep(1); \
    if ((++_sp & 255u) == 0u) { if (xb_ld(&(bar)[XB_TMO])) break; if (_sp > XB_SPIN_CAP) { atomicAdd(&(bar)[XB_TMO], 1u); break; } } } } while (0)

struct XcdBarrier {
    unsigned* bar; unsigned x;
    volatile LAS unsigned* st;
};

__device__ __forceinline__ XcdBarrier xcd_barrier_post(unsigned* bar, volatile LAS unsigned* st) {
    XcdBarrier b; b.bar = bar; b.x = xb_xcc_id(); b.st = st;
    if (threadIdx.x == 0) (void)xb_add(&bar[XB_XCNT(b.x)], 1u);
    return b;
}
__device__ __forceinline__ void xcd_barrier_complete(unsigned* bar, unsigned x, unsigned& nloc, unsigned& nx) {
    const unsigned G = gridDim.x * gridDim.y * gridDim.z;
    unsigned sum, cnt, mine, sp = 0u;
    for (;;) {
        sum = 0u; cnt = 0u; mine = 0u;
#pragma unroll
        for (unsigned j = 0; j < 16; ++j) { const unsigned c = xb_ld(&bar[XB_XCNT(j)]); sum += c; cnt += (c > 0u) ? 1u : 0u; mine = (j == x) ? c : mine; }
        if (sum == G) break;
        __builtin_amdgcn_s_sleep(1);
        if ((++sp & 255u) == 0u) { if (xb_ld(&bar[XB_TMO])) break; if (sp > XB_SPIN_CAP) { atomicAdd(&bar[XB_TMO], 1u); break; } }
    }
    nloc = mine > 0u ? mine : 1u; nx = cnt > 0u ? cnt : 1u;
}

__device__ __forceinline__ void xcd_barrier(const XcdBarrier& b) {
    asm volatile("s_waitcnt vmcnt(0)" ::: "memory");
    __syncthreads();
    if (threadIdx.x == 0) {
        unsigned* bar = b.bar;
        __builtin_amdgcn_s_waitcnt(0);
        unsigned nloc = b.st[0], nx = b.st[1];
        if (nloc == 0u) { xcd_barrier_complete(bar, b.x, nloc, nx); b.st[0] = nloc; b.st[1] = nx; }
        const unsigned old = xb_add(&bar[XB_XSUB(b.x)], 1u);
        const unsigned gen = old / nloc;
        if (old + 1u == (gen + 1u) * nloc) {
            __builtin_amdgcn_fence(__ATOMIC_RELEASE, "agent");
            asm volatile("s_waitcnt vmcnt(0)" ::: "memory");
            const unsigned og = xb_add(&bar[XB_TOP], 1u);
            const unsigned tg = og / nx;
            if (og + 1u == (tg + 1u) * nx) xb_add(&bar[XB_TOPGEN], 1u);
            else XB_SPIN(xb_ld(&bar[XB_TOPGEN]) == tg, bar);
            __builtin_amdgcn_fence(__ATOMIC_ACQUIRE, "agent");
            xb_add(&bar[XB_XGEN(b.x)], 1u);
            asm volatile("s_waitcnt vmcnt(0)" ::: "memory");
        } else {
            XB_SPIN(xb_ld(&bar[XB_XGEN(b.x)]) == gen, bar);
            __builtin_amdgcn_fence(__ATOMIC_ACQUIRE, "agent");
            asm volatile("s_waitcnt vmcnt(0)" ::: "memory");
        }
    }
    __syncthreads();
}

constexpr size_t WS_CTL = 1 * MiB + 524288;
constexpr int LDS_ST_OFF = LDS_BYTES - 64;
template <bool WANT_PN> __device__ __forceinline__ int unit_tile(int M, int N, int G, int c, int i) {
    const int nM = M / 256, nN = N / 256, nwg = nM * nN; const long L = (long)i * G + c; if (L >= nwg) return -1;
    int wgid = (int)L; { const int q = nwg / pg8::NXCD, r = nwg % pg8::NXCD, xcd = wgid % pg8::NXCD, off = wgid / pg8::NXCD; wgid = (xcd < r ? xcd * (q + 1) : r * (q + 1) + (xcd - r) * q) + off; }
    const int nig = pg8::WGM * nN, gid = wgid / nig, fm = gid * pg8::WGM, gsz = (nM - fm) < pg8::WGM ? (nM - fm) : pg8::WGM;
    return WANT_PN ? (wgid % nig) / gsz : fm + ((wgid % nig) % gsz);
}
struct Args { const float* in[25]; float* out; unsigned char* ws; int ph_lo, ph_hi; };
constexpr int N_PHASES = 19;

template <class Epi> __device__ __forceinline__ void run_gemm(LAS unsigned char* lds, const bf16_t* A, const bf16_t* Bt, int M, int N, int K, const Epi& E) {
    pg8::Gemm g{A, Bt, M, N, K}; pg8::StaticOrder S; S.init(M, N, (int)gridDim.x, (int)blockIdx.x);
    pg8::gemm_phase<Epi, pg8::StaticOrder, true, true>(lds, g, S, E);
}

__global__ void __launch_bounds__(NTHREADS, 2) mega_fwd(Args a) {
    extern __shared__ __attribute__((aligned(16))) unsigned char lds_raw[];
    LAS unsigned char* lds = (LAS unsigned char*)lds_raw;
    cg::grid_group grid = cg::this_grid();
    const int tid = threadIdx.x, lane = tid & 63, wave = __builtin_amdgcn_readfirstlane(tid >> 6);
    const int G = gridDim.x, gw = blockIdx.x * NWAVES + wave, NGW = G * NWAVES;
    unsigned char* ws = a.ws;
    bf16_t* XB = (bf16_t*)(ws + WS_H); bf16_t* U = (bf16_t*)(ws + WS_U);
    bf16_t* VC = (bf16_t*)(ws + WS_VC); bf16_t* US = (bf16_t*)(ws + WS_US); bf16_t* YB = (bf16_t*)(ws + WS_YB); bf16_t* CAT = (bf16_t*)(ws + WS_CAT);
    bf16_t* QK = (bf16_t*)(ws + WS_QK); bf16_t* VT = (bf16_t*)(ws + WS_VT); bf16_t* OA = (bf16_t*)(ws + WS_OA);
    float* KM = (float*)(ws + WS_KMEAN); float* SST = (float*)(ws + WS_SST); float* SS = (float*)(ws + WS_SS);
    const int lo = a.ph_lo, hi = a.ph_hi;
    volatile LAS unsigned* bst = (volatile LAS unsigned*)(lds + LDS_ST_OFF);
    if (tid < 2) bst[tid] = 0u;
    __syncthreads();
    XcdBarrier xbar = xcd_barrier_post((unsigned*)(ws + WS_CTL), bst);
#define IN(k) (lo <= (k) && (k) < hi)
#define SEAM(k) do { if (IN(k) && IN((k) + 1)) xcd_barrier(xbar); } while (0)
    if (lo < 0) grid.sync();

    if (IN(0)) {
        LAS float* scr = (LAS float*)(lds + wave * 16384);
        constexpr int I_UP = (D / 64) * (FF / 32), I_DN = (FF / 64) * (D / 32), I_FFN = 2 * I_UP + I_DN;
        constexpr int I_IN = (D / 64) * (512 / 32), I_GLU = (512 / 64) * (512 / 32), I_SQ = (D / 64) * (D / 32), I_QK = (D / 64) * (2048 / 32);
        constexpr int NITEMS = 4 * I_FFN + 3 * I_IN + I_GLU + I_SQ + I_QK + I_SQ + I_SQ;
#define P0_DESC(it_, out_) do { int r = (it_); \
            if (r < 4 * I_FFN) { const int f = r / I_FFN; r -= f * I_FFN; \
                bf16_t* wup = (bf16_t*)(ws + WS_WUP + f * WUP_STRIDE); bf16_t* wdn = (bf16_t*)(ws + WS_WDN + f * WDN_STRIDE); const float* gn = a.in[1] + f * D; \
                if (r < I_UP) out_ = tr_desc(a.in[2] + (size_t)f * D * FF, FF, D, wup, FF / 32, 1, 0, gn, r); \
                else if (r < 2 * I_UP) out_ = tr_desc(a.in[3] + (size_t)f * D * FF, FF, D, wup, FF / 32, 1, 1, gn, r - I_UP); \
                else out_ = tr_desc(a.in[4] + (size_t)f * FF * D, D, FF, wdn, D / 32, 0, 0, nullptr, r - 2 * I_UP); } \
            else { r -= 4 * I_FFN; \
                if (r < I_IN) out_ = tr_desc(a.in[6], 1536, D, (bf16_t*)(ws + WS_WIN), 16, 1, 0, a.in[5], r); \
                else if (r < 2 * I_IN) out_ = tr_desc(a.in[6] + 512, 1536, D, (bf16_t*)(ws + WS_WIN), 16, 1, 1, a.in[5], r - I_IN); \
                else if (r < 3 * I_IN) out_ = tr_desc(a.in[6] + 1024, 1536, D, (bf16_t*)(ws + WS_WIN), 16, 0, 1024, a.in[5], r - 2 * I_IN); \
                else { r -= 3 * I_IN; \
                    if (r < I_GLU) out_ = tr_desc(a.in[19], 512, 512, (bf16_t*)(ws + WS_WGLU), 16, 0, 0, nullptr, r); \
                    else if (r < I_GLU + I_SQ) out_ = tr_desc(a.in[21], D, D, (bf16_t*)(ws + WS_WOUT), 32, 0, 0, nullptr, r - I_GLU); \
                    else if (r < I_GLU + I_SQ + I_QK) out_ = tr_desc(a.in[22], 3072, D, (bf16_t*)(ws + WS_WQK), 64, 0, 0, a.in[5] + D, r - I_GLU - I_SQ); \
                    else if (r < I_GLU + 2 * I_SQ + I_QK) out_ = tr_desc(a.in[22] + 2048, 3072, D, (bf16_t*)(ws + WS_WV), 32, 0, 0, a.in[5] + D, r - I_GLU - I_SQ - I_QK); \
                    else out_ = tr_desc(a.in[23], D, D, (bf16_t*)(ws + WS_WO), 32, 0, 0, nullptr, r - I_GLU - 2 * I_SQ - I_QK); } } } while (0)
        if (gw < NITEMS) {
            TrDesc dc; P0_DESC(gw, dc); float vc[32]; tr_load(dc, vc, lane);
            for (int it = gw; it < NITEMS; it += NGW) {
                TrDesc dn = dc; float vn[32];
                const bool more = it + NGW < NITEMS;
                if (more) { P0_DESC(it + NGW, dn); tr_load(dn, vn, lane); }
                tr_store(dc, vc, scr, lane);
                if (more) { dc = dn;
#pragma unroll
                    for (int i = 0; i < 32; ++i) vc[i] = vn[i]; }
            }
        }
#undef P0_DESC
        if (gw * 64 + lane < NG * NS) ssm_tables(gw * 64 + lane, a.in[11], a.in[12], a.in[13], a.in[14], a.in[18], (float*)(ws + WS_ABAR), (bf16_t*)(ws + WS_BBH), (bf16_t*)(ws + WS_BBL));
        if (gw * 64 + lane < NG * 16 * 16) ssm_ctable(gw * 64 + lane, a.in[15], a.in[16], (bf16_t*)(ws + WS_CMH), (bf16_t*)(ws + WS_CML));
        for (int i = gw * 64 + lane; i < NB * NH * 8 * HD; i += NGW * 64) KM[i] = 0.f;
        xb_rows(a.in[0], XB, SS, gw, NGW, lane);
    }
    SEAM(0);
#define BUILD_RTAB(RT, M_, N_, WANT_PN, nin) RTab RT; { int q0 = -1, q1 = -1, q2 = -1, q3 = -1; \
          for (int i = 0; i < 16; ++i) { const int pm_ = unit_tile<WANT_PN>(M_, N_, G, (int)blockIdx.x, i); if (pm_ >= 0 && pm_ != q0 && pm_ != q1 && pm_ != q2 && pm_ != q3) { if (q0 < 0) q0 = pm_; else if (q1 < 0) q1 = pm_; else if (q2 < 0) q2 = pm_; else if (q3 < 0) q3 = pm_; } } \
          const float* ssp = SS + (nin) * SSN; __syncthreads(); \
          _Pragma("unroll") for (int q = 0; q < 4; ++q) { const int pq = q == 0 ? q0 : (q == 1 ? q1 : (q == 2 ? q2 : q3)); if (pq >= 0 && tid < 256) { const int row = pq * 256 + tid; float t = 0.f; \
              _Pragma("unroll") for (int p = 0; p < 16; ++p) t += ssp[(size_t)p * T + row]; ((LAS float*)(lds + LDS_RTAB_OFF))[q * 256 + tid] = rs_of(t); } } \
          __syncthreads(); RT = RTab{(const LAS float*)(lds + LDS_RTAB_OFF), q0, q1, q2, q3}; }
#define FFN_UP(k, f, nin) if (IN(k)) { BUILD_RTAB(RT, T, 2 * FF, false, nin) EpiSwiglu E{U, RT}; \
        run_gemm(lds, XB, (const bf16_t*)(ws + WS_WUP + (f) * WUP_STRIDE), T, 2 * FF, D, E); } SEAM(k);
#define FFN_DN(k, f, xin, nout) if (IN(k)) { EpiResid E{XB, 0.5f, SS + (nout) * SSN}; run_gemm(lds, U, (const bf16_t*)(ws + WS_WDN + (f) * WDN_STRIDE), T, D, FF, E); } SEAM(k);
    FFN_UP(1, 0, 0)
    FFN_DN(2, 0, a.in[0], 1)
    if (IN(3)) { BUILD_RTAB(RT, T, 1536, false, 1) EpiWin E{VC, US, RT}; run_gemm(lds, XB, (const bf16_t*)(ws + WS_WIN), T, 1536, D, E); }
    SEAM(3);
    if (IN(4)) {
        conv_phase(lds, VC, a.in[7], a.in[8], a.in[9], a.in[10], CAT, tid, lane, wave);
        ssm_pass1(lds, US, SST, (const float*)(ws + WS_ABAR), (const bf16_t*)(ws + WS_BBH), (const bf16_t*)(ws + WS_BBL), gw, NGW, lane, wave);
    }
    SEAM(4);
    if (IN(5)) ssm_pass2(lds, US, SST, YB, (const float*)(ws + WS_ABAR), (const bf16_t*)(ws + WS_BBH), (const bf16_t*)(ws + WS_BBL), (const bf16_t*)(ws + WS_CMH), (const bf16_t*)(ws + WS_CML), a.in[17], gw, NGW, lane, wave);
    SEAM(5);
    if (IN(6)) { EpiGlu E{YB, a.in[20], CAT}; run_gemm(lds, YB, (const bf16_t*)(ws + WS_WGLU), T, 512, 512, E); }
    SEAM(6);
    if (IN(7)) { EpiResid E{XB, 1.f, SS + 2 * SSN}; run_gemm(lds, CAT, (const bf16_t*)(ws + WS_WOUT), T, D, D, E); }
    SEAM(7);
    FFN_UP(8, 1, 2)
    FFN_DN(9, 1, X, 3)
    FFN_UP(10, 2, 3)
    FFN_DN(11, 2, X, 4)
    if (IN(12)) {
        { BUILD_RTAB(RT, T, 2048, false, 4) EpiBf E{QK, 2048, 4, C2, RT, KM}; run_gemm(lds, XB, (const bf16_t*)(ws + WS_WQK), T, 2048, D, E); }
        { BUILD_RTAB(RT, D, T, true, 4) EpiVT E{VT, RT}; run_gemm(lds, (const bf16_t*)(ws + WS_WV), XB, D, T, D, E); }
    }
    SEAM(12);
    if (IN(14)) {
        const int vcu = (G % 8 == 0) ? (int)(blockIdx.x % 8) * (G / 8) + (int)(blockIdx.x / 8) : (int)blockIdx.x;
        for (int pu = vcu; pu < NB * NH * 4; pu += G) { const int bh = pu >> 2, j = pu & 3, b = bh >> 3, h = bh & 7;
            attn_unit(lds, QK, VT, KM, OA, b, h, 7 - j, tid, lane, wave);
            attn_unit(lds, QK, VT, KM, OA, b, h, j, tid, lane, wave); }
    }
    SEAM(14);
    if (IN(15)) { EpiResid E{XB, 1.f, SS + 5 * SSN}; run_gemm(lds, OA, (const bf16_t*)(ws + WS_WO), T, D, D, E); }
    SEAM(15);
    FFN_UP(16, 3, 5)
    FFN_DN(17, 3, X, 6)
    if (IN(18)) final_rows(XB, a.out, a.in[24], SS + 6 * SSN, gw, NGW, lane);
#undef IN
#undef SEAM
}

extern "C" void kernel_launch(void* const* d_in, const int* in_sizes, int n_in, void* d_out, int out_size, void* d_ws, size_t ws_size, hipStream_t stream) {
    static int grid = 0;
    if (grid == 0) {
        if (n_in != 25 || in_sizes[0] != T * D || out_size != T * D || ws_size < WS_END) { fprintf(stderr, "kernel_launch: unexpected shapes (n_in %d, in0 %d, out %d, ws %zu < %zu)\n", n_in, n_in > 0 ? in_sizes[0] : -1, out_size, ws_size, (size_t)WS_END); grid = -1; return; }
        int dev = 0, cus = 0, per_cu = 0;
        (void)hipGetDevice(&dev); (void)hipDeviceGetAttribute(&cus, hipDeviceAttributeMultiprocessorCount, dev);
        if (hipFuncSetAttribute((const void*)mega_fwd, hipFuncAttributeMaxDynamicSharedMemorySize, LDS_BYTES) != hipSuccess) { fprintf(stderr, "kernel_launch: hipFuncSetAttribute failed\n"); grid = -1; return; }
        if (hipOccupancyMaxActiveBlocksPerMultiprocessor(&per_cu, (const void*)mega_fwd, NTHREADS, LDS_BYTES) != hipSuccess || per_cu < 1) { fprintf(stderr, "kernel_launch: occupancy query says %d\n", per_cu); per_cu = 1; }
        (void)hipGetLastError();
        grid = cus * 1;
        fprintf(stderr, "kernel_launch: grid %d (cus %d, per_cu %d)\n", grid, cus, per_cu);
    }
    if (grid < 0) return;
    Args a{};
    for (int i = 0; i < 25; ++i) a.in[i] = (const float*)d_in[i];
    a.out = (float*)d_out; a.ws = (unsigned char*)d_ws; a.ph_lo = 0; a.ph_hi = N_PHASES;
    if (hipMemsetAsync((char*)d_ws + WS_CTL, 0, 16384, stream) != hipSuccess) { fprintf(stderr, "kernel_launch: memset failed\n"); return; }
    void* args[] = {&a};
    hipError_t e = hipLaunchCooperativeKernel((const void*)mega_fwd, dim3(grid), dim3(NTHREADS), args, LDS_BYTES, stream);
    if (e != hipSuccess) fprintf(stderr, "kernel_launch: cooperative launch failed: %s (grid %d)\n", hipGetErrorString(e), grid);
}
```
